# Optimizing an MI355X kernel written in HIP

```python
import math
import jax
import jax.numpy as jnp
from jax import lax
import numpy as np

D_MODEL = 2048
BATCH = 4
SEQ = 4096
DEPTH = 2

HEAD_DIM = 128
N_HEADS = D_MODEL // HEAD_DIM
MIX_WIDTH = N_HEADS * HEAD_DIM
HEADS_A = N_HEADS // 2
HEADS_B = N_HEADS // 4
HEADS_C = N_HEADS - HEADS_A - HEADS_B
DILATED_PATTERNS = ((128, 1), (512, 4), (2048, 16))
DIFF_HEAD_DIM = HEAD_DIM // 2
DIFF_QBLK = 128
GRID_W = 64
NA_ROWS = 8
NA_COLS = 16
N_EXPERTS = 64
TOP_K = 8
N_GROUPS = 8
TOPK_GROUPS = 4
EXPERT_DIM = D_MODEL // 4
SHARED_DIM = EXPERT_DIM
ROUTED_SCALE = 2.5
MOE_BLOCK = 256
NORM_EPS = 1e-6
SUBLN_EPS = 1e-5
NEG_INF = -1e30

kernel_name = "hybrid_dilated_diff_neighborhood_moe_encoder"

F32 = jnp.float32


def rms_norm(x, g, eps=NORM_EPS):
    xf = x.astype(F32)
    y = xf * lax.rsqrt(jnp.mean(xf * xf, axis=-1, keepdims=True) + eps)
    return (y * g.astype(F32)).astype(x.dtype)


def modulate(h, shift, scale):
    return h * (1 + scale[:, None, :]) + shift[:, None, :]


def alibi_slopes(n):
    def pow2(m):
        start = 2.0 ** (-8.0 / m)
        return [start ** (i + 1) for i in range(m)]
    p = 2 ** int(math.floor(math.log2(n)))
    s = pow2(p) + pow2(2 * p)[0::2][: n - p]
    return jnp.asarray(s, dtype=F32)


def dilated_branch(q, k, v, slopes, window, dilation):
    B, H, S, hd = q.shape
    half = window // (2 * dilation)
    L = S // dilation
    nb = -(-L // half)
    Lp = nb * half

    def to_sub(z):
        return z.reshape(B, H, L, dilation, hd).transpose(0, 1, 3, 2, 4)

    qs = jnp.pad(to_sub(q), ((0, 0), (0, 0), (0, 0), (0, Lp - L), (0, 0)))
    qs = qs.reshape(B, H, dilation, nb, half, hd)

    def key_blocks(z):
        zp = jnp.pad(to_sub(z), ((0, 0), (0, 0), (0, 0), (half, Lp - L + half), (0, 0)))
        zp = zp.reshape(B, H, dilation, nb + 2, half, hd)
        return jnp.concatenate([zp[:, :, :, :-2], zp[:, :, :, 1:-1], zp[:, :, :, 2:]], axis=4)

    kb = key_blocks(k)
    vb = key_blocks(v)
    qi = jnp.arange(nb)[:, None] * half + jnp.arange(half)[None, :]
    ki = jnp.arange(nb)[:, None] * half - half + jnp.arange(3 * half)[None, :]
    rel = jnp.abs(ki[:, None, :] - qi[:, :, None])
    valid = (rel <= half) & (ki[:, None, :] >= 0) & (ki[:, None, :] < L)
    dist = (rel * dilation).astype(F32)
    s = jnp.einsum('bhrnqd,bhrnkd->bhrnqk', qs, kb).astype(F32) * (hd ** -0.5)
    s = s - slopes[None, :, None, None, None, None] * dist
    s = jnp.where(valid, s, NEG_INF)
    lse = jax.nn.logsumexp(s, axis=-1)
    p = jnp.exp(s - lse[..., None])
    o = jnp.einsum('bhrnqk,bhrnkd->bhrnqd', p.astype(v.dtype), vb)
    o = o.reshape(B, H, dilation, Lp, hd)[:, :, :, :L].transpose(0, 1, 3, 2, 4).reshape(B, H, S, hd)
    lse = lse.reshape(B, H, dilation, Lp)[:, :, :, :L].transpose(0, 1, 3, 2).reshape(B, H, S)
    return o, lse


def dilated_mixture_attention(q, k, v, slopes):
    outs, lses = [], []
    for window, dilation in DILATED_PATTERNS:
        o_p, lse_p = dilated_branch(q, k, v, slopes, window, dilation)
        outs.append(o_p)
        lses.append(lse_p)
    wts = jax.nn.softmax(jnp.stack(lses, axis=0), axis=0)
    o = jnp.sum(wts[..., None] * jnp.stack(outs, axis=0).astype(F32), axis=0)
    return o.astype(v.dtype)


def differential_attention(q, k, v, slopes, lam, lambda_init, subln_g):
    B, H, S, _, dh = q.shape
    nq = S // DIFF_QBLK
    qb = q.reshape(B, H, nq, DIFF_QBLK, 2, dh).transpose(2, 0, 1, 3, 4, 5)
    kpos = jnp.arange(S)

    def block(args):
        qi, start = args
        s = jnp.einsum('bhqcd,bhkcd->bhcqk', qi, k).astype(F32) * (dh ** -0.5)
        dist = jnp.abs(start + jnp.arange(DIFF_QBLK)[:, None] - kpos[None, :]).astype(F32)
        s = s - slopes[None, :, None, None, None] * dist
        p = jax.nn.softmax(s, axis=-1)
        a = p[:, :, 0] - lam * p[:, :, 1]
        return jnp.einsum('bhqk,bhkd->bhqd', a.astype(v.dtype), v)

    o = lax.map(block, (qb, jnp.arange(nq) * DIFF_QBLK))
    o = o.transpose(1, 2, 0, 3, 4).reshape(B, H, S, 2 * dh)
    o = rms_norm(o, subln_g, SUBLN_EPS).astype(F32) * (1.0 - lambda_init)
    return o.astype(v.dtype)


def neighborhood_attention(q, k, v, rpb):
    B, H, S, hd = q.shape
    R = S // GRID_W
    kr = min(NA_ROWS, R)
    r = jnp.arange(R)
    rows_idx = jnp.clip(r - kr // 2, 0, R - kr)[:, None] + jnp.arange(kr)[None, :]
    col = jnp.arange(GRID_W)
    cstart = jnp.clip(col - NA_COLS // 2, 0, GRID_W - NA_COLS)
    col_ok = (col[None, :] >= cstart[:, None]) & (col[None, :] < cstart[:, None] + NA_COLS)
    dr_idx = rows_idx - r[:, None] + NA_ROWS - 1
    dc_idx = jnp.clip(col[None, :] - col[:, None] + NA_COLS - 1, 0, 2 * NA_COLS - 2)
    bias = rpb[:, dr_idx[:, None, :, None], dc_idx[None, :, None, :]].astype(F32)
    qg = q.reshape(B, H, R, GRID_W, hd)
    kg = k.reshape(B, H, R, GRID_W, hd)[:, :, rows_idx]
    vg = v.reshape(B, H, R, GRID_W, hd)[:, :, rows_idx]
    s = jnp.einsum('bhrqd,bhrjkd->bhrqjk', qg, kg).astype(F32) * (hd ** -0.5) + bias[None]
    s = jnp.where(col_ok[:, None, :], s, NEG_INF)
    p = jax.nn.softmax(s.reshape(B, H, R, GRID_W, kr * GRID_W), axis=-1).reshape(s.shape)
    o = jnp.einsum('bhrqjk,bhrjkd->bhrqd', p.astype(v.dtype), vg)
    return o.reshape(B, H, S, hd)


def moe_ffn(h, router_w, router_bias, w_gate, w_up, w_down, s_gate, s_up, s_down):
    N, D = h.shape
    E = w_gate.shape[0]
    scores = jax.nn.sigmoid((h @ router_w).astype(F32))
    sel = scores + router_bias.astype(F32)
    grp_score = jnp.sum(lax.top_k(sel.reshape(N, N_GROUPS, E // N_GROUPS), 2)[0], axis=-1)
    _, gidx = lax.top_k(grp_score, TOPK_GROUPS)
    gmask = jnp.any(gidx[:, :, None] == jnp.arange(N_GROUPS)[None, None, :], axis=1)
    sel = jnp.where(jnp.repeat(gmask, E // N_GROUPS, axis=1), sel, NEG_INF)
    _, idx = lax.top_k(sel, TOP_K)
    gate = jnp.take_along_axis(scores, idx, axis=-1)
    gate = gate / jnp.sum(gate, axis=-1, keepdims=True) * ROUTED_SCALE

    A = N * TOP_K
    e_flat = idx.reshape(A)
    order = jnp.argsort(e_flat)
    e_sorted = e_flat[order]
    tok_sorted = (order // TOP_K).astype(jnp.int32)
    gate_sorted = gate.reshape(A)[order]
    counts = jnp.bincount(e_flat, length=E)
    starts = jnp.cumsum(counts) - counts
    padded = (counts + MOE_BLOCK - 1) // MOE_BLOCK * MOE_BLOCK
    pend = jnp.cumsum(padded)
    pstart = pend - padded
    dest = pstart[e_sorted] + jnp.arange(A) - starts[e_sorted]
    n_blocks = -(-(A + E * (MOE_BLOCK - 1)) // MOE_BLOCK)
    P = n_blocks * MOE_BLOCK
    tok_buf = jnp.zeros((P,), jnp.int32).at[dest].set(tok_sorted)
    gate_buf = jnp.zeros((P,), F32).at[dest].set(gate_sorted)
    block_expert = jnp.minimum(
        jnp.searchsorted(pend, jnp.arange(n_blocks) * MOE_BLOCK, side='right'), E - 1)

    def expert_block(args):
        rows, gts, e = args
        xb = h[rows]
        u = jax.nn.silu(xb @ w_gate[e]) * (xb @ w_up[e])
        return (u @ w_down[e]).astype(F32) * gts[:, None]

    y = lax.map(expert_block, (tok_buf.reshape(n_blocks, MOE_BLOCK),
                               gate_buf.reshape(n_blocks, MOE_BLOCK), block_expert))
    routed = jnp.zeros((N, D), F32).at[tok_buf].add(y.reshape(P, D))
    shared = (jax.nn.silu(h @ s_gate) * (h @ s_up)) @ s_down
    return (routed + shared.astype(F32)).astype(h.dtype)


def setup_inputs(seed: int = 0) -> dict:
    key = jax.random.key(seed)
    ks = jax.random.split(key, 32)
    L, D = DEPTH, D_MODEL

    def nrm(k, shape, scale):
        return jax.random.normal(k, shape, F32) * scale

    return {
        'x': nrm(ks[0], (BATCH, SEQ, D), 1.0),
        'c': nrm(ks[1], (BATCH, D), 1.0),
        'ada_w': nrm(ks[2], (L, D, 6 * D), 0.5 * D ** -0.5),
        'ada_b': nrm(ks[3], (L, 6 * D), 0.02),
        'norm_mix_g': 1.0 + nrm(ks[4], (L, D), 0.02),
        'norm_ffn_g': 1.0 + nrm(ks[5], (L, D), 0.02),
        'w_in': nrm(ks[6], (L, D, 3 * MIX_WIDTH), D ** -0.5),
        'lambda_q1': nrm(ks[7], (L, DIFF_HEAD_DIM), 0.1),
        'lambda_k1': nrm(ks[8], (L, DIFF_HEAD_DIM), 0.1),
        'lambda_q2': nrm(ks[9], (L, DIFF_HEAD_DIM), 0.1),
        'lambda_k2': nrm(ks[10], (L, DIFF_HEAD_DIM), 0.1),
        'subln_g': 1.0 + nrm(ks[11], (L, HEAD_DIM), 0.02),
        'rpb': nrm(ks[12], (L, HEADS_C, 2 * NA_ROWS - 1, 2 * NA_COLS - 1), 0.1),
        'w_out': nrm(ks[13], (L, MIX_WIDTH, D), MIX_WIDTH ** -0.5),
        'router_w': nrm(ks[14], (L, D, N_EXPERTS), D ** -0.5),
        'router_bias': nrm(ks[15], (L, N_EXPERTS), 0.01),
        'exp_w_gate': nrm(ks[16], (L, N_EXPERTS, D, EXPERT_DIM), D ** -0.5),
        'exp_w_up': nrm(ks[17], (L, N_EXPERTS, D, EXPERT_DIM), D ** -0.5),
        'exp_w_down': nrm(ks[18], (L, N_EXPERTS, EXPERT_DIM, D), EXPERT_DIM ** -0.5),
        'sh_w_gate': nrm(ks[19], (L, D, SHARED_DIM), D ** -0.5),
        'sh_w_up': nrm(ks[20], (L, D, SHARED_DIM), D ** -0.5),
        'sh_w_down': nrm(ks[21], (L, SHARED_DIM, D), SHARED_DIM ** -0.5),
        'final_g': 1.0 + nrm(ks[22], (D,), 0.02),
    }


def reference(x, c, ada_w, ada_b, norm_mix_g, norm_ffn_g, w_in, lambda_q1, lambda_k1,
              lambda_q2, lambda_k2, subln_g, rpb, w_out, router_w, router_bias,
              exp_w_gate, exp_w_up, exp_w_down, sh_w_gate, sh_w_up, sh_w_down, final_g):
    B, S, D = x.shape
    slopes = alibi_slopes(HEADS_A + HEADS_B)
    slopes_a, slopes_b = slopes[:HEADS_A], slopes[HEADS_A:]
    cond = jax.nn.silu(c)
    for l in range(DEPTH):
        mod = cond @ ada_w[l] + ada_b[l]
        sh1, sc1, g1, sh2, sc2, g2 = jnp.split(mod, 6, axis=-1)

        h = modulate(rms_norm(x, norm_mix_g[l]), sh1, sc1)
        qkv = (h @ w_in[l]).reshape(B, S, 3, N_HEADS, HEAD_DIM).transpose(2, 0, 3, 1, 4)
        q, k, v = qkv[0], qkv[1], qkv[2]
        a0, b0 = HEADS_A, HEADS_A + HEADS_B

        o_a = dilated_mixture_attention(q[:, :a0], k[:, :a0], v[:, :a0], slopes_a)

        lambda_init = 0.8 - 0.6 * math.exp(-0.3 * l)
        lam = (jnp.exp(jnp.sum(lambda_q1[l].astype(F32) * lambda_k1[l].astype(F32)))
               - jnp.exp(jnp.sum(lambda_q2[l].astype(F32) * lambda_k2[l].astype(F32)))
               + lambda_init)
        qd = q[:, a0:b0].reshape(B, HEADS_B, S, 2, DIFF_HEAD_DIM)
        kd = k[:, a0:b0].reshape(B, HEADS_B, S, 2, DIFF_HEAD_DIM)
        o_b = differential_attention(qd, kd, v[:, a0:b0], slopes_b, lam, lambda_init, subln_g[l])

        o_c = neighborhood_attention(q[:, b0:], k[:, b0:], v[:, b0:], rpb[l])

        o = jnp.concatenate([o_a, o_b, o_c], axis=1).transpose(0, 2, 1, 3).reshape(B, S, MIX_WIDTH)
        x = x + g1[:, None, :] * (o @ w_out[l])

        h2 = modulate(rms_norm(x, norm_ffn_g[l]), sh2, sc2)
        f = moe_ffn(h2.reshape(B * S, D), router_w[l], router_bias[l], exp_w_gate[l], exp_w_up[l],
                    exp_w_down[l], sh_w_gate[l], sh_w_up[l], sh_w_down[l])
        x = x + g2[:, None, :] * f.reshape(B, S, D)
    return rms_norm(x, final_g)
```

```cpp
#include <hip/hip_runtime.h>
#include <cstdio>
#include <cstdint>

#ifndef MK_PER_PHASE
#define MK_PER_PHASE 0
#endif
#ifndef DUP_MASK
#define DUP_MASK 0
#endif
#ifndef MK_DEBUG
#define MK_DEBUG 0
#endif

#define LAS __attribute__((address_space(3)))
#define GAS __attribute__((address_space(1)))
typedef unsigned short bf16_t;
typedef short bf16x8 __attribute__((ext_vector_type(8)));
typedef short s16x4 __attribute__((ext_vector_type(4)));
typedef float f32x2 __attribute__((ext_vector_type(2)));
typedef float f32x4 __attribute__((ext_vector_type(4)));
typedef float f32x16 __attribute__((ext_vector_type(16)));
typedef unsigned u32x2 __attribute__((ext_vector_type(2)));
typedef unsigned u32x4 __attribute__((ext_vector_type(4)));

constexpr int DM = 2048, NBATCH = 4, SEQ = 4096, NTOK = NBATCH * SEQ, NLAYER = 2, HD = 128, QKVW = 3 * DM;
constexpr int NE = 64, TOPK = 8, EDIM = 512, MODW = 6 * DM;
constexpr int NEX = NE + 1;
constexpr int MAXROWS = NTOK * TOPK + NE * 256 + NTOK;
constexpr float NORM_EPS = 1e-6f, SUBLN_EPS = 1e-5f;

constexpr size_t MiB = (size_t)1 << 20;
constexpr size_t WS_CTL = 0, CTL_ZERO_BYTES = 1 * MiB;
constexpr size_t WS_MOD = 1 * MiB;
constexpr size_t WS_TOK = 2 * MiB;
constexpr size_t WS_SLOT = 6 * MiB;
constexpr size_t WS_ALSE = 7 * MiB;
constexpr size_t WS_WRH = WS_MOD + 448 * 1024;
constexpr size_t WS_WRL = WS_ALSE + 1536 * 1024;
constexpr size_t WS_WIN = 9 * MiB;
constexpr size_t WS_WOUT = 57 * MiB;
constexpr size_t WS_WGU = 73 * MiB;
constexpr size_t WS_WD = 593 * MiB;
constexpr size_t WS_XA = 853 * MiB;
constexpr size_t WS_XB = 981 * MiB;
constexpr size_t WS_H = 1109 * MiB;
constexpr size_t WS_OV = 1173 * MiB;
constexpr size_t WS_QKV = WS_OV, WS_OCAT = WS_OV + 192 * MiB, WS_APART = WS_OV + 256 * MiB;
constexpr size_t WS_UBUF = WS_OV, WS_YBUF = WS_OV + 160 * MiB;
constexpr size_t WS_END = WS_OV + 800 * MiB;
static_assert(WS_APART + (size_t)3 * NTOK * 1024 * 2 <= WS_END && WS_YBUF + (size_t)MAXROWS * DM * 2 <= WS_END && (size_t)MAXROWS * EDIM * 2 <= 160 * MiB, "ws map");
constexpr int CW_BAR = 4096;
constexpr int CW_CNT = 8192;
constexpr int CW_FAIL = 8448;
constexpr int CW_KMAX = 8704;
constexpr int CW_QB = 8832;
constexpr int CW_QM = 9856;
constexpr int CW_QC2 = 9088, CW_QA = 9344, CW_QV = 9600;

constexpr int RING_BYTES = 131072;
constexpr int MISC_OFF = RING_BYTES;
constexpr int TAB_BS_OFF = MISC_OFF + 64;
constexpr int TAB_CNT_OFF = MISC_OFF + 64 + 320;
constexpr int TAB_UNIT_OFF = MISC_OFF + 1024;
constexpr int LDS_BYTES = 147456;

__device__ __forceinline__ unsigned cvt_pk_bf16(float lo, float hi) { unsigned r; asm volatile("v_cvt_pk_bf16_f32 %0, %1, %2" : "=v"(r) : "v"(lo), "v"(hi)); return r; }
__device__ __forceinline__ float bf2f(unsigned short b) { return __uint_as_float(((unsigned)b) << 16); }
__device__ __forceinline__ float bflo(unsigned w) { return __uint_as_float(w << 16); }
__device__ __forceinline__ float bfhi(unsigned w) { return __uint_as_float(w & 0xffff0000u); }
__device__ __forceinline__ int lane_now() { int l = (int)__builtin_amdgcn_mbcnt_hi(~0u, __builtin_amdgcn_mbcnt_lo(~0u, 0u)); asm volatile("" : "+v"(l)); return l; }
__device__ __forceinline__ int shx(int v, int off) { return __builtin_amdgcn_ds_bpermute((lane_now() ^ off) << 2, v); }
__device__ __forceinline__ float shx(float v, int off) { return __int_as_float(__builtin_amdgcn_ds_bpermute((lane_now() ^ off) << 2, __float_as_int(v))); }
__device__ __forceinline__ int shf(int v, int src) { return __builtin_amdgcn_ds_bpermute(src << 2, v); }
__device__ __forceinline__ float shf(float v, int src) { return __int_as_float(__builtin_amdgcn_ds_bpermute(src << 2, __float_as_int(v))); }
__device__ __forceinline__ float rdl(float v, int src) { return __int_as_float(__builtin_amdgcn_readlane(__float_as_int(v), src)); }
template <int CTRL> __device__ __forceinline__ float dppf(float v) { return __int_as_float(__builtin_amdgcn_update_dpp(0, __float_as_int(v), CTRL, 0xf, 0xf, true)); }
template <int CTRL> __device__ __forceinline__ int dppi(int v) { return __builtin_amdgcn_update_dpp(0, v, CTRL, 0xf, 0xf, true); }
__device__ __forceinline__ float gmax8(float v) { v = fmaxf(v, dppf<0xB1>(v)); v = fmaxf(v, dppf<0x4E>(v)); return fmaxf(v, dppf<0x141>(v)); }
__device__ __forceinline__ int gmin8(int v) { v = min(v, dppi<0xB1>(v)); v = min(v, dppi<0x4E>(v)); return min(v, dppi<0x141>(v)); }
__device__ __forceinline__ float row_sum16(float v) { v += dppf<0xB1>(v); v += dppf<0x4E>(v); v += dppf<0x141>(v); return v + dppf<0x140>(v); }
__device__ __forceinline__ float wave_sum(float v) { v = row_sum16(v); return (rdl(v, 0) + rdl(v, 16)) + (rdl(v, 32) + rdl(v, 48)); }
__device__ __forceinline__ int launder_i(int v) { asm volatile("" : "+v"(v)); return v; }
__device__ __forceinline__ size_t opq0() { size_t z = 0; asm volatile("" : "+s"(z)); return z; }
__device__ __forceinline__ float sat8(float x) { return __builtin_amdgcn_fmed3f(x, -448.0f, 448.0f); }
__device__ __forceinline__ unsigned pk4_fp8w(float a, float b, float c, float d) { int w = __builtin_amdgcn_cvt_pk_fp8_f32(a, b, 0, false); w = __builtin_amdgcn_cvt_pk_fp8_f32(c, d, w, true); return (unsigned)w; }
__device__ __forceinline__ unsigned pk4_fp8(float a, float b, float c, float d) { int w = __builtin_amdgcn_cvt_pk_fp8_f32(sat8(a), sat8(b), 0, false); w = __builtin_amdgcn_cvt_pk_fp8_f32(sat8(c), sat8(d), w, true); return (unsigned)w; }
typedef int v4i_t __attribute__((ext_vector_type(4)));
typedef int v8i_t __attribute__((ext_vector_type(8)));
#define LDS_WAIT() asm volatile("s_waitcnt lgkmcnt(0)" ::: "memory")
#define VM_WAIT() asm volatile("s_waitcnt vmcnt(0)" ::: "memory")

#define XB_TMO      128
#define XB_XCNT(j)  (256  + 64 * (j))
#define XB_XSUB(j)  (1280 + 64 * (j))
#define XB_XGEN(j)  (2304 + 64 * (j))
#define XB_TOP      3328
#define XB_TOPGEN   3392
#define XCD_BAR_WORDS 3456
#define XB_SPIN_CAP (1u << 20)

__device__ __forceinline__ unsigned xb_ld(unsigned* p)              { return __hip_atomic_load(p, __ATOMIC_RELAXED, __HIP_MEMORY_SCOPE_AGENT); }
__device__ __forceinline__ unsigned xb_add(unsigned* p, unsigned v) { return __hip_atomic_fetch_add(p, v, __ATOMIC_RELAXED, __HIP_MEMORY_SCOPE_AGENT); }
__device__ __forceinline__ unsigned xb_xcc_id() { return (unsigned)__builtin_amdgcn_s_getreg((3 << 11) | 20) & 0xFu; }
#define XB_SPIN(cond, bar) do { unsigned _sp = 0; while (cond) { __builtin_amdgcn_s_sleep(1); \
    if ((++_sp & 255u) == 0u) { if (xb_ld(&(bar)[XB_TMO])) break; if (_sp > XB_SPIN_CAP) { atomicAdd(&(bar)[XB_TMO], 1u); break; } } } } while (0)

struct XcdBarrier { unsigned* bar; unsigned x; volatile LAS unsigned* st; };

__device__ __forceinline__ XcdBarrier xcd_barrier_post(unsigned* bar, volatile LAS unsigned* st) {
    XcdBarrier b; b.bar = bar; b.x = xb_xcc_id(); b.st = st;
    if (threadIdx.x == 0) (void)xb_add(&bar[XB_XCNT(b.x)], 1u);
    return b;
}
__device__ __forceinline__ void xcd_barrier_complete(unsigned* bar, unsigned x, unsigned& nloc, unsigned& nx) {
    const unsigned G = gridDim.x * gridDim.y * gridDim.z;
    unsigned sum, cnt, mine, sp = 0u;
    for (;;) {
        sum = 0u; cnt = 0u; mine = 0u;
#pragma unroll
        for (unsigned j = 0; j < 16; ++j) { const unsigned c = xb_ld(&bar[XB_XCNT(j)]); sum += c; cnt += (c > 0u) ? 1u : 0u; mine = (j == x) ? c : mine; }
        if (sum == G) break;
        __builtin_amdgcn_s_sleep(1);
        if ((++sp & 255u) == 0u) { if (xb_ld(&bar[XB_TMO])) break; if (sp > XB_SPIN_CAP) { atomicAdd(&bar[XB_TMO], 1u); break; } }
    }
    nloc = mine > 0u ? mine : 1u; nx = cnt > 0u ? cnt : 1u;
}
__device__ __forceinline__ void xcd_barrier(const XcdBarrier& b) {
    asm volatile("s_waitcnt vmcnt(0)" ::: "memory");
    __syncthreads();
    if (threadIdx.x == 0) {
        unsigned* bar = b.bar + opq0();
        __builtin_amdgcn_s_waitcnt(0);
        unsigned nloc = b.st[0], nx = b.st[1];
        if (nloc == 0u) { xcd_barrier_complete(bar, b.x, nloc, nx); b.st[0] = nloc; b.st[1] = nx; }
        const unsigned old = xb_add(&bar[XB_XSUB(b.x)], 1u);
        const unsigned gen = old / nloc;
        if (old + 1u == (gen + 1u) * nloc) {
            __builtin_amdgcn_fence(__ATOMIC_RELEASE, "agent");
            asm volatile("s_waitcnt vmcnt(0)" ::: "memory");
            const unsigned og = xb_add(&bar[XB_TOP], 1u);
            const unsigned tg = og / nx;
            if (og + 1u == (tg + 1u) * nx) xb_add(&bar[XB_TOPGEN], 1u);
            else XB_SPIN(xb_ld(&bar[XB_TOPGEN]) == tg, bar);
            __builtin_amdgcn_fence(__ATOMIC_ACQUIRE, "agent");
            xb_add(&bar[XB_XGEN(b.x)], 1u);
            asm volatile("s_waitcnt vmcnt(0)" ::: "memory");
        } else {
            XB_SPIN(xb_ld(&bar[XB_XGEN(b.x)]) == gen, bar);
            __builtin_amdgcn_fence(__ATOMIC_ACQUIRE, "agent");
            asm volatile("s_waitcnt vmcnt(0)" ::: "memory");
        }
    }
    __syncthreads();
}

namespace pg8 {
constexpr int BM = 256, BK = 64, HALF = 128, HTB = HALF * BK * 2, STAGE_BYTES = 8 * HTB, NXCD = 8, WGM = 8;
__host__ __device__ __forceinline__ int lds_byte(int r, int c) { const int st = (r >> 4) * 2 + (c >> 5), rr = r & 15, cc = c & 31, ob = rr * 64 + cc * 2; return st * 1024 + (ob ^ (((ob >> 9) & 1) << 5)); }
__host__ __device__ __forceinline__ void stage_rc(int b, int& R, int& C) { const int st = b / 1024, sb = b % 1024, swz = sb ^ (((sb >> 9) & 1) << 5); R = (st >> 1) * 16 + swz / 64; C = (st & 1) * 32 + (swz % 64) / 2; }
__host__ __device__ __forceinline__ int perm32(int rho) { const int n = rho >> 4, i = rho & 15; return 8 * (i >> 2) + 4 * n + (i & 3); }

struct Unit { int pm, pn, e, orow0, cnt; };

struct SchedPlain {
    static constexpr bool GATHERS = false;
    const char* abase; const char* bbase; int nM, nN, nwg, G, c, rb;
    __device__ void init(const void* A, const void* Bt, int M, int N, int K_, int esz, int G_, int c_) { abase = (const char*)A; bbase = (const char*)Bt; nM = M / BM; nN = N / BM; nwg = nM * nN; G = G_; c = c_; rb = K_ * esz; }
    __device__ __forceinline__ bool next(int i, Unit& u) const {
        const long L = (long)i * G + c; if (L >= nwg) return false;
        int wgid = (int)L; { const int q = nwg / NXCD, r = nwg % NXCD, xcd = wgid % NXCD, off = wgid / NXCD; wgid = (xcd < r ? xcd * (q + 1) : r * (q + 1) + (xcd - r) * q) + off; }
        const int nig = WGM * nN, gid = wgid / nig, fm = gid * WGM, gsz = (nM - fm) < WGM ? (nM - fm) : WGM;
        u.pm = fm + ((wgid % nig) % gsz); u.pn = (wgid % nig) / gsz; u.e = 0; u.orow0 = u.pm * BM; u.cnt = BM; return true;
    }
    __device__ __forceinline__ unsigned arow_off(const Unit& u, int r) const { return (unsigned)(u.pm * BM + r) * (unsigned)rb; }
    __device__ __forceinline__ const char* btile(const Unit& u) const { return bbase + (size_t)u.pn * BM * rb; }
};
template <bool GATHER> struct SchedMoE {
    static constexpr bool GATHERS = GATHER;
    const char* abase; const char* wbase; size_t wstride; const int* toklist; const LAS int* bs; const LAS int* cn; int npn, G, c, rb;
    const LAS int* ut;
    __device__ __forceinline__ bool search(int i, Unit& u) const {
        const int L = i * G + c, total = bs[NEX] * npn; if (L >= total) return false;
        int lo = 0, hi = NE;
        while (lo < hi) { const int mid = (lo + hi + 1) >> 1; if (bs[mid] * npn <= L) lo = mid; else hi = mid - 1; }
        const int e = lo, rem = L - bs[e] * npn, nb = bs[e + 1] - bs[e];
        u.e = e; u.pn = rem / nb; u.pm = rem % nb; u.orow0 = (bs[e] + u.pm) * BM; u.cnt = cn[e] - u.pm * BM; return true;
    }
    __device__ __forceinline__ void build_units(LAS int* tab, int tid) const {
        if (tid < 32) { Unit u; const bool ok = search(tid, u); LAS int* t = tab + tid * 8; t[0] = ok ? u.pm : -1; t[1] = u.pn; t[2] = u.e; t[3] = u.orow0; t[4] = u.cnt; }
        __syncthreads();
    }
    __device__ __forceinline__ bool next(int i, Unit& u) const {
        if (i >= 32) return false;
        const LAS int* t = ut + i * 8; const int pm = t[0]; if (pm < 0) return false;
        u.pm = pm; u.pn = t[1]; u.e = t[2]; u.orow0 = t[3]; u.cnt = t[4]; return true;
    }
    __device__ __forceinline__ unsigned arow_off(const Unit& u, int r) const {
        if (GATHER) { int tok; if (u.e == NE) tok = u.pm * BM + r; else tok = (r < u.cnt) ? toklist[u.e * NTOK + u.pm * BM + r] : 0; return (unsigned)tok * (unsigned)rb; }
        else return (unsigned)(u.orow0 + r) * (unsigned)rb;
    }
    __device__ __forceinline__ const char* btile(const Unit& u) const { return wbase + (size_t)u.e * wstride + (size_t)u.pn * BM * rb; }
};

struct EpiBf16 {
    static constexpr bool PERM = true; static constexpr int BH = 32, NVM = 16;
    static __device__ __forceinline__ int brow(int R) { return 64 * (R >> 5) + 8 * ((R & 15) >> 2) + 4 * ((R >> 4) & 1) + (R & 3); }
    bf16_t* O; int ldc; float qscale;
    __device__ __forceinline__ void operator()(const f32x4 (&acc)[2][2][4][2], const Unit& u, int wr, int wc, int fr, int fq) const {
        fr = launder_i(fr); fq = launder_i(fq);
        const float sc = (u.pn == 4 || u.pn == 5) ? qscale : 1.0f;
        const int row0 = u.orow0 + wr * 64 + fr, col0 = u.pn * BM + wc * 64 + 8 * fq;
#pragma unroll
        for (int ai = 0; ai < 2; ++ai)
#pragma unroll
            for (int m = 0; m < 4; ++m) { bf16_t* rowp = O + (size_t)(row0 + ai * HALF + m * 16) * ldc + col0;
#pragma unroll
                for (int bj = 0; bj < 2; ++bj) { const f32x4 v0 = acc[ai][bj][m][0], v1 = acc[ai][bj][m][1];
                    u32x4 w; w.x = cvt_pk_bf16(v0[0] * sc, v0[1] * sc); w.y = cvt_pk_bf16(v0[2] * sc, v0[3] * sc); w.z = cvt_pk_bf16(v1[0] * sc, v1[1] * sc); w.w = cvt_pk_bf16(v1[2] * sc, v1[3] * sc);
                    *(u32x4*)(rowp + bj * 32) = w; } }
    }
};
struct EpiF8 {
    static constexpr bool PERM = true; static constexpr int BH = 8, NVM = 8;
    static __device__ __forceinline__ int brow(int R) { return 64 * (R >> 5) + 16 * ((R & 15) >> 2) + 4 * ((R >> 4) & 1) + (R & 3); }
    unsigned char* O; int ldc;
    __device__ __forceinline__ void operator()(const f32x4 (&acc)[2][2][4][2], const Unit& u, int wr, int wc, int fr, int fq) const {
        fr = launder_i(fr); fq = launder_i(fq);
        const int row0 = u.orow0 + wr * 64 + fr, col0 = u.pn * BM + wc * 64 + 16 * fq;
#pragma unroll
        for (int ai = 0; ai < 2; ++ai)
#pragma unroll
            for (int m = 0; m < 4; ++m) { unsigned char* rowp = O + (size_t)(row0 + ai * HALF + m * 16) * ldc + col0;
                const f32x4 a0 = acc[ai][0][m][0], a1 = acc[ai][0][m][1], b0 = acc[ai][1][m][0], b1 = acc[ai][1][m][1];
                u32x4 w; w.x = pk4_fp8(a0[0], a0[1], a0[2], a0[3]); w.y = pk4_fp8(a1[0], a1[1], a1[2], a1[3]); w.z = pk4_fp8(b0[0], b0[1], b0[2], b0[3]); w.w = pk4_fp8(b1[0], b1[1], b1[2], b1[3]);
                *(u32x4*)rowp = w; }
    }
};
struct EpiResid {
    static constexpr bool PERM = true; static constexpr int BH = 8, NVM = 0;
    static __device__ __forceinline__ int brow(int R) { return 64 * (R >> 5) + 16 * ((R & 15) >> 2) + 4 * ((R >> 4) & 1) + (R & 3); }
    const float* xin32; const bf16_t* xin16; bf16_t* out; const float* gate;
    __device__ __forceinline__ void operator()(const f32x4 (&acc)[2][2][4][2], const Unit& u, int wr, int wc, int fr, int fq) const {
        fr = launder_i(fr); fq = launder_i(fq);
        const int row0 = u.orow0 + wr * 64 + fr, col0 = u.pn * BM + wc * 64 + 16 * fq, b = u.orow0 / SEQ;
        f32x4 gv[4];
#pragma unroll
        for (int q = 0; q < 4; ++q) gv[q] = *(const f32x4*)(gate + (size_t)b * MODW + col0 + 4 * q);
#pragma unroll
        for (int ai = 0; ai < 2; ++ai)
#pragma unroll
            for (int m = 0; m < 4; ++m) { const size_t off = (size_t)(row0 + ai * HALF + m * 16) * DM + col0;
                f32x4 xs[4];
                if (xin32) {
#pragma unroll
                    for (int q = 0; q < 4; ++q) xs[q] = *(const f32x4*)(xin32 + off + 4 * q);
                } else { const u32x4 w0 = *(const u32x4*)(xin16 + off), w1 = *(const u32x4*)(xin16 + off + 8);
                    xs[0] = (f32x4){bflo(w0.x), bfhi(w0.x), bflo(w0.y), bfhi(w0.y)}; xs[1] = (f32x4){bflo(w0.z), bfhi(w0.z), bflo(w0.w), bfhi(w0.w)};
                    xs[2] = (f32x4){bflo(w1.x), bfhi(w1.x), bflo(w1.y), bfhi(w1.y)}; xs[3] = (f32x4){bflo(w1.z), bfhi(w1.z), bflo(w1.w), bfhi(w1.w)}; }
                u32x4 o[2];
#pragma unroll
                for (int bj = 0; bj < 2; ++bj) { const f32x4 r0 = xs[2 * bj] + gv[2 * bj] * acc[ai][bj][m][0], r1 = xs[2 * bj + 1] + gv[2 * bj + 1] * acc[ai][bj][m][1];
                    o[bj].x = cvt_pk_bf16(r0[0], r0[1]); o[bj].y = cvt_pk_bf16(r0[2], r0[3]); o[bj].z = cvt_pk_bf16(r1[0], r1[1]); o[bj].w = cvt_pk_bf16(r1[2], r1[3]); }
                *(u32x4*)(out + off) = o[0]; *(u32x4*)(out + off + 8) = o[1];
                if (m & 1) asm volatile("" ::: "memory"); }
    }
};
struct EpiSwiglu {
    static constexpr bool PERM = true; static constexpr int BH = 4;
    static __device__ __forceinline__ int brow(int R) { return 64 * (R >> 5) + 32 * ((R >> 4) & 1) + 8 * ((R & 15) >> 2) + (R & 3); }
    unsigned char* U;
    __device__ __forceinline__ void operator()(const f32x4 (&acc)[2][2][4][2], const Unit& u, int wr, int wc, int fr, int fq) const {
        fr = launder_i(fr); fq = launder_i(fq);
        const int row0 = u.orow0 + wr * 64 + fr, j0 = u.pn * 128 + wc * 32 + 8 * fq;
#pragma unroll
        for (int ai = 0; ai < 2; ++ai)
#pragma unroll
            for (int m = 0; m < 4; ++m) { unsigned char* rowp = U + (size_t)(row0 + ai * HALF + m * 16) * EDIM + j0; u32x2 w;
#pragma unroll
                for (int bj = 0; bj < 2; ++bj) { const f32x4 g = acc[ai][bj][m][0], up = acc[ai][bj][m][1]; f32x4 v;
#pragma unroll
                    for (int t = 0; t < 4; ++t) v[t] = g[t] * __builtin_amdgcn_rcpf(1.0f + __expf(-g[t])) * up[t];
                    w[bj] = pk4_fp8(v[0], v[1], v[2], v[3]); }
                *(u32x2*)rowp = w; }
    }
};

template <int RB, bool F8, class Epi, class Sched>
__device__ __forceinline__ void gemm_phase(LAS unsigned char* lds, const Sched& S, const Epi& E) {
    const int tid = launder_i((int)threadIdx.x), wid = __builtin_amdgcn_readfirstlane(tid >> 6), lane = tid & 63, wr = wid >> 2, wc = wid & 3, fr = lane & 15, fq = lane >> 4;
    constexpr int nt = RB / 128;
    static_assert(RB % 256 == 0 && RB >= 512, "row bytes: multiple of 256, >= 512");
    unsigned voffB[2];
#pragma unroll
    for (int i = 0; i < 2; ++i) { int R, C; stage_rc(tid * 16 + i * 8192, R, C); const int Rb = Epi::brow(R); voffB[i] = (unsigned)(Rb * RB + C * 2); }
#define PG8_AOFF(u, vo0, vo1) do { _Pragma("unroll") for (int i_ = 0; i_ < 2; ++i_) { int R_, C_; stage_rc(launder_i(tid) * 16 + i_ * 8192, R_, C_); \
        (vo0)[i_] = S.arow_off((u), R_) + (unsigned)(C_ * 2); (vo1)[i_] = S.arow_off((u), HALF + R_) + (unsigned)(C_ * 2); } } while (0)
    constexpr size_t kstep = (size_t)(BK * 2);
    constexpr size_t hstepB = (size_t)Epi::BH * RB;
    const unsigned ldsw = (unsigned)wid * 1024u;
    const int aoff = lds_byte(wr * 64 + fr, fq * 8), boff = lds_byte(wc * 32 + fr, fq * 8);
#define PG8_SA(b, h) (((b) * 2 + (h)) * HTB)
#define PG8_SB(b, h) ((4 + (b) * 2 + (h)) * HTB)
#define PG8_STAGE(bufoff, gbase, voff) do { _Pragma("unroll") for (int _i = 0; _i < 2; ++_i) \
        __builtin_amdgcn_global_load_lds((const unsigned*)((const char*)(gbase) + (voff)[_i]), (LAS unsigned*)(lds + (bufoff) + ldsw + _i * 8192), 16, 0, 0); } while (0)
#define PG8_LD32(dstv, off) do { const v4i_t lo_ = *(const LAS v4i_t*)(lds + (off)), hi_ = *(const LAS v4i_t*)(lds + (off) + 1024); (dstv) = __builtin_shufflevector(lo_, hi_, 0, 1, 2, 3, 4, 5, 6, 7); } while (0)
#define PG8_LDA(dst, b, h) do { _Pragma("unroll") for (int m = 0; m < 4; ++m) PG8_LD32(dst[m].v, PG8_SA(b, h) + aoff + m * 2048); } while (0)
#define PG8_LDB(dst, b, h) do { _Pragma("unroll") for (int n = 0; n < 2; ++n) PG8_LD32(dst[n].v, PG8_SB(b, h) + boff + n * 2048); } while (0)
#define PG8_LO(x) __builtin_bit_cast(bf16x8, __builtin_shufflevector((x), (x), 0, 1, 2, 3))
#define PG8_HI(x) __builtin_bit_cast(bf16x8, __builtin_shufflevector((x), (x), 4, 5, 6, 7))
#define PG8_MMA(ai, bj, At, Bt) do { __builtin_amdgcn_s_setprio(1); \
        if constexpr (!F8) { _Pragma("unroll") for (int m = 0; m < 4; ++m) _Pragma("unroll") for (int n = 0; n < 2; ++n) { \
            acc[ai][bj][m][n] = __builtin_amdgcn_mfma_f32_16x16x32_bf16(PG8_LO(Bt[n].v), PG8_LO(At[m].v), acc[ai][bj][m][n], 0, 0, 0); \
            acc[ai][bj][m][n] = __builtin_amdgcn_mfma_f32_16x16x32_bf16(PG8_HI(Bt[n].v), PG8_HI(At[m].v), acc[ai][bj][m][n], 0, 0, 0); } } \
        else { _Pragma("unroll") for (int m = 0; m < 4; ++m) _Pragma("unroll") for (int n = 0; n < 2; ++n) \
            asm volatile("v_mfma_scale_f32_16x16x128_f8f6f4 %0, %1, %2, %0, %3, %4 op_sel_hi:[0,0,0]" : "+v"(acc[ai][bj][m][n]) : "v"(Bt[n].v), "v"(At[m].v), "v"(scl_w), "v"(scl_a)); } \
        __builtin_amdgcn_s_setprio(0); } while (0)
#define PG8_MMAZ(ai, bj, At, Bt) do { __builtin_amdgcn_s_setprio(1); \
        _Pragma("unroll") for (int m = 0; m < 4; ++m) _Pragma("unroll") for (int n = 0; n < 2; ++n) \
            asm volatile("v_mfma_scale_f32_16x16x128_f8f6f4 %0, %1, %2, 0, %3, %4 op_sel_hi:[0,0,0]" : "=&v"(acc[ai][bj][m][n]) : "v"(Bt[n].v), "v"(At[m].v), "v"(scl_w), "v"(scl_a)); \
        __builtin_amdgcn_s_setprio(0); } while (0)
#define PG8_WAIT_V(n) asm volatile("s_waitcnt vmcnt(" #n ")" ::: "memory")
#define PG8_WAIT_L(n) asm volatile("s_waitcnt lgkmcnt(" #n ")" ::: "memory")
#define PG8_BAR __builtin_amdgcn_s_barrier()
#define PG8_SCHED __builtin_amdgcn_sched_barrier(0)
    Unit cur, nxt; int ui = 0;
    if (!S.next(0, cur)) return;
    int scl_w = 0x7a7a7a7a, scl_a = 0x7f7f7f7f;
    asm volatile("" : "+v"(scl_w), "+v"(scl_a));
    f32x4 acc[2][2][4][2];
    if constexpr (!F8) {
#pragma unroll
    for (int a = 0; a < 2; ++a)
#pragma unroll
        for (int b = 0; b < 2; ++b)
#pragma unroll
            for (int m = 0; m < 4; ++m)
#pragma unroll
                for (int n = 0; n < 2; ++n) acc[a][b][m][n] = (f32x4){0.f, 0.f, 0.f, 0.f};
    }
    struct Frag { v8i_t v; };
    Frag At[4], B0[2], B1[2];
    unsigned cvo0[2], cvo1[2];
    PG8_AOFF(cur, cvo0, cvo1);
    const char* const Ab = S.abase; const char* cB = S.btile(cur);
    PG8_STAGE(PG8_SB(0, 0), cB, voffB); PG8_STAGE(PG8_SB(0, 1), cB + hstepB, voffB); PG8_STAGE(PG8_SA(0, 0), Ab, cvo0); PG8_STAGE(PG8_SA(0, 1), Ab, cvo1);
    if (wr == 1) PG8_BAR;
    PG8_WAIT_V(2); PG8_BAR;
    PG8_STAGE(PG8_SB(1, 0), cB + kstep, voffB); PG8_STAGE(PG8_SA(1, 0), Ab + kstep, cvo0); PG8_STAGE(PG8_SB(1, 1), cB + hstepB + kstep, voffB);
    PG8_WAIT_V(6); PG8_BAR;
    for (;;) {
        const bool has_next = S.next(ui + 1, nxt);
        const char* nB = has_next ? S.btile(nxt) : cB;

        for (int t = 0; t < nt; t += 2) {
            const bool last = (t == nt - 2);
            const char* a1 = Ab + (size_t)(t + 1) * kstep;
            const char* a2 = last ? Ab : Ab + (size_t)(t + 2) * kstep; const char* b2 = last ? nB : cB + (size_t)(t + 2) * kstep;
            const char* a3 = a2 + kstep; const char* b3 = b2 + kstep;
            if (last) {
                PG8_STAGE(PG8_SA(1, 1), a1, cvo1);
                if (has_next) { PG8_AOFF(nxt, cvo0, cvo1); } PG8_SCHED; }
            PG8_LDB(B0, 0, 0); PG8_LDB(B1, 0, 1); PG8_SCHED; PG8_LDA(At, 0, 0); if (!last) PG8_STAGE(PG8_SA(1, 1), a1, cvo1);
            PG8_WAIT_V(8); PG8_WAIT_L(0); PG8_BAR; if (F8 && t == 0) { PG8_MMAZ(0, 0, At, B0); PG8_MMAZ(0, 1, At, B1); } else { PG8_MMA(0, 0, At, B0); PG8_MMA(0, 1, At, B1); } PG8_BAR; PG8_SCHED;
            PG8_LDA(At, 0, 1); PG8_STAGE(PG8_SB(0, 0), b2, voffB); PG8_STAGE(PG8_SB(0, 1), b2 + hstepB, voffB); PG8_STAGE(PG8_SA(0, 0), a2, cvo0);
            PG8_WAIT_V(8); PG8_WAIT_L(0); PG8_BAR; if (F8 && t == 0) { PG8_MMAZ(1, 0, At, B0); PG8_MMAZ(1, 1, At, B1); } else { PG8_MMA(1, 0, At, B0); PG8_MMA(1, 1, At, B1); } PG8_BAR; PG8_SCHED;
            PG8_LDB(B0, 1, 0); PG8_LDB(B1, 1, 1); PG8_SCHED; PG8_LDA(At, 1, 0); PG8_STAGE(PG8_SA(0, 1), a2, cvo1);
            PG8_WAIT_V(8); PG8_WAIT_L(0); PG8_BAR; PG8_MMA(0, 0, At, B0); PG8_MMA(0, 1, At, B1); PG8_BAR; PG8_SCHED;
            PG8_LDA(At, 1, 1); PG8_STAGE(PG8_SB(1, 0), b3, voffB); PG8_STAGE(PG8_SB(1, 1), b3 + hstepB, voffB); PG8_STAGE(PG8_SA(1, 0), a3, cvo0);
            PG8_WAIT_V(8); PG8_WAIT_L(0); PG8_BAR; PG8_MMA(1, 0, At, B0); PG8_MMA(1, 1, At, B1); PG8_BAR; PG8_SCHED;
        }
        if (wr == 0) PG8_BAR;
        if constexpr (F8) asm volatile("s_nop 15\n\ts_nop 15" ::: "memory");
        E(acc, cur, wr, wc, fr, fq);
        if (!has_next) break;
        if constexpr (!F8) {
#pragma unroll
        for (int a = 0; a < 2; ++a)
#pragma unroll
            for (int b = 0; b < 2; ++b)
#pragma unroll
                for (int m = 0; m < 4; ++m)
#pragma unroll
                    for (int n = 0; n < 2; ++n) acc[a][b][m][n] = (f32x4){0.f, 0.f, 0.f, 0.f};
        }
        cur = nxt; cB = nB; ++ui;
        if (wr == 1) PG8_BAR;
    }
    PG8_WAIT_V(0);
    PG8_BAR;
#undef PG8_AOFF
#undef PG8_SA
#undef PG8_SB
#undef PG8_STAGE
#undef PG8_LDA
#undef PG8_LDB
#undef PG8_MMA
#undef PG8_MMAZ
#undef PG8_WAIT_V
#undef PG8_WAIT_L
#undef PG8_BAR
#undef PG8_SCHED
}
}

namespace att {
constexpr int SHM_V = 64 * 128 * 2, SHM_K = 64 * 128 * 2;
constexpr int WSC_OFF = 2 * SHM_V + 2 * SHM_K;
constexpr int TAB_OFF = WSC_OFF + 8 * 256;
constexpr int RNG_OFF = TAB_OFF + 7680;
constexpr float THR = 8.f;
#define KSWZ(row, colB) ((row) * 256 + ((colB) ^ (((row) & 7) << 4)))
#define SBAR() __builtin_amdgcn_sched_barrier(0)
__device__ __forceinline__ int crow(int r, int hi) { return (r & 3) + 8 * (r >> 2) + 4 * hi; }
template <int MODE> struct Sc { static constexpr float SCALE = (MODE == 1) ? 0.125f : 0.088388347648318440f; };

template <int MODE>
__device__ __forceinline__ void partialSM(f32x16& p0, f32x16& p1, float& m_reg, float& mn, float& alpha) {
  constexpr float SCALE = Sc<MODE>::SCALE;
  constexpr float C = SCALE * 1.4426950408889634f;
  float pmax = p0[0];
#pragma unroll
  for (int r = 1; r < 16; ++r) pmax = fmaxf(pmax, p0[r]);
#pragma unroll
  for (int r = 0; r < 16; ++r) pmax = fmaxf(pmax, p1[r]);
  { auto rr = __builtin_amdgcn_permlane32_swap(__float_as_uint(pmax), __float_as_uint(pmax), false, false);
    pmax = fmaxf(__uint_as_float(rr[0]), __uint_as_float(rr[1])); }
  if (__builtin_expect(__all(pmax - m_reg <= THR / SCALE), 1)) { mn = m_reg; alpha = 1.f; }
  else { mn = fmaxf(m_reg, pmax); alpha = __builtin_amdgcn_exp2f((m_reg - mn) * C); m_reg = mn; }
  const float mnC = -mn * C;
#pragma unroll
  for (int r = 0; r < 16; ++r) p0[r] = fmaf(p0[r], C, mnC);
#pragma unroll
  for (int r = 0; r < 16; ++r) p1[r] = fmaf(p1[r], C, mnC);
#pragma unroll
  for (int r = 0; r < 16; ++r) p0[r] = __builtin_amdgcn_exp2f(p0[r]);
}
__device__ __forceinline__ void finishSM(f32x16& p0, f32x16& p1, float alpha, float& l_reg, bf16x8& pa0, bf16x8& pa1, bf16x8& pa2, bf16x8& pa3) {
#pragma unroll
  for (int r = 0; r < 16; ++r) p1[r] = __builtin_amdgcn_exp2f(p1[r]);
  float ps = 0;
#pragma unroll
  for (int r = 0; r < 16; ++r) ps += p0[r];
#pragma unroll
  for (int r = 0; r < 16; ++r) ps += p1[r];
  { auto rr = __builtin_amdgcn_permlane32_swap(__float_as_uint(ps), __float_as_uint(ps), false, false);
    ps = __uint_as_float(rr[0]) + __uint_as_float(rr[1]); }
  l_reg = l_reg * alpha + ps;
#define PK4(P, BASE, OUT) do { unsigned a0 = cvt_pk_bf16(P[BASE + 0], P[BASE + 1]), a1 = cvt_pk_bf16(P[BASE + 2], P[BASE + 3]);   \
    unsigned b0 = cvt_pk_bf16(P[BASE + 4], P[BASE + 5]), b1 = cvt_pk_bf16(P[BASE + 6], P[BASE + 7]);                              \
    auto r0 = __builtin_amdgcn_permlane32_swap(a0, b0, false, false); auto r1 = __builtin_amdgcn_permlane32_swap(a1, b1, false, false); \
    u32x4 w = {r0[0], r1[0], r0[1], r1[1]}; OUT = *reinterpret_cast<bf16x8*>(&w); } while (0)
  PK4(p0, 0, pa0); PK4(p0, 8, pa1); PK4(p1, 0, pa2); PK4(p1, 8, pa3);
#undef PK4
}
template <int NQ, bool ZERO = true>
__device__ __forceinline__ void qkt(f32x16& p0, f32x16& p1, const LAS char* Ks, const bf16x8* qr, int r32, int hi, int kcb) {
  if (ZERO) { p0 = f32x16{}; p1 = f32x16{}; }
#pragma unroll
  for (int d0 = 0; d0 < NQ; ++d0) { const int cb = kcb + (d0 * 16 + hi * 8) * 2;
    const bf16x8 b0 = *reinterpret_cast<const LAS bf16x8*>(Ks + KSWZ(r32, cb));
    const bf16x8 b1 = *reinterpret_cast<const LAS bf16x8*>(Ks + KSWZ(32 + r32, cb));
    p0 = __builtin_amdgcn_mfma_f32_32x32x16_bf16(b0, qr[d0], p0, 0, 0, 0);
    p1 = __builtin_amdgcn_mfma_f32_32x32x16_bf16(b1, qr[d0], p1, 0, 0, 0); }
}
__device__ __forceinline__ int v_st(int k, int c) { const int kk = (k & ~0xC) | ((k & 4) << 1) | ((k & 8) >> 1); return ((kk >> 3) * 4 + (c >> 5)) * 512 + ((kk & 7) * 32 + (c & 31)) * 2; }
__device__ __forceinline__ int v_rd_base(int lane) { return ((lane & 3) << 3) | (((lane >> 2) & 3) << 6) | (((lane >> 4) & 1) << 5) | (((lane >> 5) & 1) << 8); }
constexpr int v_rd_off(int d0, int ks, int half) { return d0 * 512 + ks * 4096 + half * 2048; }
template <int OFF> __device__ __forceinline__ s16x4 tr_read(int vb) {
  s16x4 r; asm volatile("ds_read_b64_tr_b16 %0, %1 offset:%2" : "=&v"(r) : "v"(vb), "i"(OFF) : "memory"); return r;
}
template <int D0> __device__ __forceinline__ void pv_one(f32x16& od, int vb, bf16x8 pa0, bf16x8 pa1, bf16x8 pa2, bf16x8 pa3) {
  const s16x4 l0 = tr_read<v_rd_off(D0, 0, 0)>(vb), h0 = tr_read<v_rd_off(D0, 0, 1)>(vb), l1 = tr_read<v_rd_off(D0, 1, 0)>(vb), h1 = tr_read<v_rd_off(D0, 1, 1)>(vb);
  const s16x4 l2 = tr_read<v_rd_off(D0, 2, 0)>(vb), h2 = tr_read<v_rd_off(D0, 2, 1)>(vb), l3 = tr_read<v_rd_off(D0, 3, 0)>(vb), h3 = tr_read<v_rd_off(D0, 3, 1)>(vb);
  asm volatile("s_waitcnt lgkmcnt(0)" ::: "memory"); SBAR();
#define PK(L, H) (bf16x8){L[0], L[1], L[2], L[3], H[0], H[1], H[2], H[3]}
  od = __builtin_amdgcn_mfma_f32_32x32x16_bf16(pa0, PK(l0, h0), od, 0, 0, 0);
  od = __builtin_amdgcn_mfma_f32_32x32x16_bf16(pa1, PK(l1, h1), od, 0, 0, 0);
  od = __builtin_amdgcn_mfma_f32_32x32x16_bf16(pa2, PK(l2, h2), od, 0, 0, 0);
  od = __builtin_amdgcn_mfma_f32_32x32x16_bf16(pa3, PK(l3, h3), od, 0, 0, 0);
#undef PK
}
__device__ __forceinline__ void pv_d0(f32x16* o, int vb, bf16x8 pa0, bf16x8 pa1, bf16x8 pa2, bf16x8 pa3) {
  pv_one<0>(o[0], vb, pa0, pa1, pa2, pa3); pv_one<1>(o[1], vb, pa0, pa1, pa2, pa3); pv_one<2>(o[2], vb, pa0, pa1, pa2, pa3); pv_one<3>(o[3], vb, pa0, pa1, pa2, pa3);
}

struct Item {
  const bf16_t* qkv;
  int tokbase, dil;
  int q0;
  int head;
  int t0, nt;
  float coef;
  bf16_t* out; int out_ld, out_col;
  float* lse;
  float lam, outscale; const float* subg; float kmax2a, kmax2b;
  const float* rpb;
};

template <int MODE>
__device__ __forceinline__ void attn_item(const Item& it, LAS char* lds) {
  constexpr float SCALE = Sc<MODE>::SCALE;
  constexpr int NQ = (MODE == 1) ? 4 : 8;
  const int tid = launder_i((int)threadIdx.x), wid = __builtin_amdgcn_readfirstlane(tid >> 6), lane = tid & 63, r32 = lane & 31, hi = lane >> 5;
  const int sub = (MODE == 1) ? (wid >> 2) : 0;
  const int wq = (MODE == 1) ? (wid & 3) : wid;
  const int q0w = it.q0 + 32 * wq;
  LAS char* V_lds = lds; LAS char* K_lds = lds + 2 * SHM_V;
  LAS float* wsc = (LAS float*)(lds + WSC_OFF) + wid * 64; LAS float* li_l = wsc; LAS float* al_l = wsc + 32;
  LAS float* tab = (LAS float*)(lds + TAB_OFF);
  const size_t rstride = (size_t)it.dil * QKVW;
  const bf16_t* base = it.qkv + (size_t)it.tokbase * QKVW;
  bf16x8 qr[NQ];
  { const bf16_t* Qw = base + (size_t)(q0w + r32) * rstride + it.head * HD + sub * 64 + hi * 8;
#pragma unroll
    for (int d0 = 0; d0 < NQ; ++d0) qr[d0] = *reinterpret_cast<const bf16x8*>(Qw + d0 * 16); }
  float m_reg = -1e30f, l_reg = 0.f; f32x16 o[4] = {};
  int t_first = it.t0, n_tiles = it.nt;
  bool nomax = false;
  if (MODE == 1) {
    constexpr float C = SCALE * 1.4426950408889634f;
    const bf16_t* Kw = base + (size_t)(q0w + r32) * rstride + DM + it.head * HD + sub * 64 + hi * 8;
    float qq = 0.f, qk = 0.f;
#pragma unroll
    for (int d0 = 0; d0 < NQ; ++d0) { const bf16x8 kf = *reinterpret_cast<const bf16x8*>(Kw + d0 * 16);
#pragma unroll
      for (int e = 0; e < 8; ++e) { const float qf = bf2f((unsigned short)qr[d0][e]), kv = bf2f((unsigned short)kf[e]); qq = fmaf(qf, qf, qq); qk = fmaf(qf, kv, qk); } }
    { auto r0 = __builtin_amdgcn_permlane32_swap(__float_as_uint(qq), __float_as_uint(qq), false, false); qq = __uint_as_float(r0[0]) + __uint_as_float(r0[1]);
      auto r1 = __builtin_amdgcn_permlane32_swap(__float_as_uint(qk), __float_as_uint(qk), false, false); qk = __uint_as_float(r1[0]) + __uint_as_float(r1[1]); }
    const float kmx = sqrtf(sub ? it.kmax2b : it.kmax2a), qn = sqrtf(qq);
    const float R = (qn * kmx * 1.01f + 152.0f + C - qk) / (it.coef * C);
    m_reg = qk + 8.0f;
    nomax = __all(qn * kmx - m_reg <= 100.0f);
    const int Ri = (int)fminf(R, 1.0e6f) + 2;
    int lo = q0w + r32 - Ri, hi2 = q0w + r32 + Ri;
#pragma unroll
    for (int off = 1; off < 64; off <<= 1) { lo = min(lo, shx(lo, off)); hi2 = max(hi2, shx(hi2, off)); }
    LAS int* rng = (LAS int*)(lds + RNG_OFF);
    __syncthreads();
    if (tid == 0) { rng[0] = launder_i(0x7fffffff); rng[1] = launder_i(-0x7fffffff); }
    __syncthreads();
    if (lane == 0) { __hip_atomic_fetch_min(&rng[0], lo, __ATOMIC_RELAXED, __HIP_MEMORY_SCOPE_WORKGROUP); __hip_atomic_fetch_max(&rng[1], hi2, __ATOMIC_RELAXED, __HIP_MEMORY_SCOPE_WORKGROUP); }
    __syncthreads();
    int tlo = rng[0] >> 6, thi = rng[1] >> 6;
    tlo = tlo < it.t0 ? it.t0 : tlo; thi = thi > it.t0 + it.nt - 1 ? it.t0 + it.nt - 1 : thi;
    t_first = tlo; n_tiles = thi - tlo + 1;
  }
  const int sr = tid >> 4, sc = (tid & 15) * 8, vst0 = v_st(sr, sc), vst1 = v_st(32 + sr, sc);
  const int vb0 = (int)(unsigned)(uintptr_t)V_lds + v_rd_base(lane);
  const bf16_t* Kg = base + DM + it.head * HD + sc;
  const bf16_t* Vg = base + 2 * DM + it.head * HD + sc;
  bf16x8 vs0, vs1, ks0, ks1;
#define SLOAD(t) do { const size_t r0_ = (size_t)(64 * (t) + sr) * rstride, r1_ = r0_ + 32 * rstride; \
    vs0 = *reinterpret_cast<const bf16x8*>(Vg + r0_); vs1 = *reinterpret_cast<const bf16x8*>(Vg + r1_); \
    ks0 = *reinterpret_cast<const bf16x8*>(Kg + r0_); ks1 = *reinterpret_cast<const bf16x8*>(Kg + r1_); } while (0)
#define SWRITE(b) do { *reinterpret_cast<LAS bf16x8*>(V_lds + (b) * SHM_V + vst0) = vs0; *reinterpret_cast<LAS bf16x8*>(V_lds + (b) * SHM_V + vst1) = vs1; const int kc_ = sc * 2; \
    *reinterpret_cast<LAS bf16x8*>(K_lds + (b) * SHM_K + KSWZ(sr, kc_)) = ks0; *reinterpret_cast<LAS bf16x8*>(K_lds + (b) * SHM_K + KSWZ(32 + sr, kc_)) = ks1; } while (0)
  __syncthreads();
  if (MODE == 2) {
    for (int i = tid; i < 15 * 128; i += 512) { const int dr = i >> 7, dc = (i & 127) - 48; tab[i] = (dc >= 0 && dc < 31) ? it.rpb[dr * 31 + dc] * (1.0f / SCALE) : 0.f; }
  }
  if constexpr (MODE == 1) {
#define SLOADK(t) do { const size_t r0_ = (size_t)(64 * (t) + sr) * rstride; ks0 = *reinterpret_cast<const bf16x8*>(Kg + r0_); ks1 = *reinterpret_cast<const bf16x8*>(Kg + r0_ + 32 * rstride); } while (0)
#define SLOADV(t) do { const size_t r0_ = (size_t)(64 * (t) + sr) * rstride; vs0 = *reinterpret_cast<const bf16x8*>(Vg + r0_); vs1 = *reinterpret_cast<const bf16x8*>(Vg + r0_ + 32 * rstride); } while (0)
#define SWRITEK(b) do { const int kc_ = sc * 2; *reinterpret_cast<LAS bf16x8*>(K_lds + (b) * SHM_K + KSWZ(sr, kc_)) = ks0; *reinterpret_cast<LAS bf16x8*>(K_lds + (b) * SHM_K + KSWZ(32 + sr, kc_)) = ks1; } while (0)
#define SWRITEV(b) do { *reinterpret_cast<LAS bf16x8*>(V_lds + (b) * SHM_V + vst0) = vs0; *reinterpret_cast<LAS bf16x8*>(V_lds + (b) * SHM_V + vst1) = vs1; } while (0)
#define QKB(P0, P1, MR, t, kb) do { const float dq_ = (float)(q0w + r32 - 64 * (t) - 4 * hi); MR = m_reg; \
    if (64 * (t) + 63 <= q0w) { const float k_ = -cfc * dq_ - m_reg; \
      _Pragma("unroll") for (int r = 0; r < 16; ++r) { const float c_ = (float)((r & 3) + 8 * (r >> 2)); P0[r] = fmaf(cfc, c_, k_); P1[r] = fmaf(cfc, c_ + 32.f, k_); } } \
    else if (64 * (t) >= q0w + 31) { const float k_ = cfc * dq_ - m_reg; \
      _Pragma("unroll") for (int r = 0; r < 16; ++r) { const float c_ = (float)((r & 3) + 8 * (r >> 2)); P0[r] = fmaf(-cfc, c_, k_); P1[r] = fmaf(-cfc, c_ + 32.f, k_); } } \
    else { const float nm_ = -m_reg; _Pragma("unroll") for (int r = 0; r < 16; ++r) { const float c_ = (float)((r & 3) + 8 * (r >> 2)); P0[r] = fmaf(-cfc, fabsf(dq_ - c_), nm_); P1[r] = fmaf(-cfc, fabsf(dq_ - c_ - 32.f), nm_); } } \
    qkt<NQ, false>(P0, P1, K_lds + (kb) * SHM_K, qr, r32, hi, sub * 128); } while (0)
#define SMPV(P0, P1, MR, vbuf) do { float alpha_ = 1.f; bf16x8 pa0, pa1, pa2, pa3; \
    if (!nomax) { \
    float pm_ = P0[0]; _Pragma("unroll") for (int r = 1; r < 16; ++r) pm_ = fmaxf(pm_, P0[r]); _Pragma("unroll") for (int r = 0; r < 16; ++r) pm_ = fmaxf(pm_, P1[r]); \
    { auto rr_ = __builtin_amdgcn_permlane32_swap(__float_as_uint(pm_), __float_as_uint(pm_), false, false); pm_ = fmaxf(__uint_as_float(rr_[0]), __uint_as_float(rr_[1])); } \
    const float sh_ = m_reg - MR; \
    if (__builtin_expect(!__all(pm_ <= THRL && sh_ == 0.f), 0)) { const float dl_ = fmaxf(pm_ - sh_, 0.f), sub_ = sh_ + dl_; alpha_ = __builtin_amdgcn_exp2f(-dl_); m_reg += dl_; \
      _Pragma("unroll") for (int r = 0; r < 16; ++r) { P0[r] -= sub_; P1[r] -= sub_; } \
      if (__any(alpha_ < 1.f)) { if (hi == 0) al_l[r32] = alpha_; asm volatile("s_waitcnt lgkmcnt(0)" ::: "memory"); \
        _Pragma("unroll") for (int d = 0; d < 4; ++d) _Pragma("unroll") for (int r = 0; r < 16; ++r) o[d][r] *= al_l[crow(r, hi)]; } } } \
    _Pragma("unroll") for (int r = 0; r < 16; ++r) P0[r] = __builtin_amdgcn_exp2f(P0[r]); \
    finishSM(P0, P1, alpha_, l_reg, pa0, pa1, pa2, pa3); SBAR(); pv_d0(o, vb0 + (vbuf) * SHM_V, pa0, pa1, pa2, pa3); } while (0)
#define BSTEP(j, C0, C1, CM, N0, N1, NM, CB, NB) do { __syncthreads(); \
    if ((j) + 2 < T) SLOADK(t_first + (j) + 2); if ((j) + 1 < T) SLOADV(t_first + (j) + 1); \
    if ((j) + 1 < T) QKB(N0, N1, NM, t_first + (j) + 1, NB); SBAR(); \
    SMPV(C0, C1, CM, CB); \
    if ((j) + 2 < T) SWRITEK(CB); if ((j) + 1 < T) SWRITEV(NB); } while (0)
    const int T = n_tiles;
    SLOADK(t_first); SLOADV(t_first); SWRITEK(0); SWRITEV(0);
    if (T > 1) { SLOADK(t_first + 1); SWRITEK(1); }
    __syncthreads();
    f32x16 pA0, pA1, pB0, pB1; float mrA, mrB = 0.f;
    constexpr float THRL = THR * 1.4426950408889634f;
    const float cfc = it.coef * (SCALE * 1.4426950408889634f);
    QKB(pA0, pA1, mrA, t_first, 0);
    for (int j = 0; j < T; j += 2) {
      BSTEP(j, pA0, pA1, mrA, pB0, pB1, mrB, 0, 1);
      if (j + 1 < T) BSTEP(j + 1, pB0, pB1, mrB, pA0, pA1, mrA, 1, 0);
    }
#undef SLOADK
#undef SLOADV
#undef SWRITEK
#undef SWRITEV
#undef QKB
#undef SMPV
#undef BSTEP
  } else {
  struct Stg { bf16x8 v0, v1, k0, k1; } sA, sB;
#define SLD(S, t) do { const size_t r0_ = (size_t)(64 * (t) + sr) * rstride, r1_ = r0_ + 32 * rstride; \
    S.v0 = *reinterpret_cast<const bf16x8*>(Vg + r0_); S.v1 = *reinterpret_cast<const bf16x8*>(Vg + r1_); S.k0 = *reinterpret_cast<const bf16x8*>(Kg + r0_); S.k1 = *reinterpret_cast<const bf16x8*>(Kg + r1_); } while (0)
#define SWR(S, b) do { *reinterpret_cast<LAS bf16x8*>(V_lds + (b) * SHM_V + vst0) = S.v0; *reinterpret_cast<LAS bf16x8*>(V_lds + (b) * SHM_V + vst1) = S.v1; const int kc_ = sc * 2; \
    *reinterpret_cast<LAS bf16x8*>(K_lds + (b) * SHM_K + KSWZ(sr, kc_)) = S.k0; *reinterpret_cast<LAS bf16x8*>(K_lds + (b) * SHM_K + KSWZ(32 + sr, kc_)) = S.k1; } while (0)
  SLD(sA, t_first); SWR(sA, 0);
  if (n_tiles > 1) SLD(sB, t_first + 1);
  const int rq = (MODE == 2) ? (it.q0 >> 6) + (wid >> 1) : 0;
  const int cq = (MODE == 2) ? 32 * (wid & 1) + r32 : 0;
  const int rs = (MODE == 2) ? (rq - 4 < 0 ? 0 : (rq - 4 > 56 ? 56 : rq - 4)) : 0;
  const int cst = (MODE == 2) ? (cq - 8 < 0 ? 0 : (cq - 8 > 48 ? 48 : cq - 8)) : 0;
  for (int j0 = 0; j0 < n_tiles; j0 += 2) {
#pragma unroll
   for (int hf = 0; hf < 2; ++hf) {
    const int j = j0 + hf; if (j >= n_tiles) break;
    const int t = t_first + j, buf = hf;
    __syncthreads();
    if (j + 2 < n_tiles) { if (hf == 0) SLD(sA, t + 2); else SLD(sB, t + 2); }
    bool rel;
    if (MODE == 0) rel = (64 * t + 63 >= q0w - 64) && (64 * t <= q0w + 31 + 64);
    else if (MODE == 1) rel = true;
    else rel = (t >= rs) && (t <= rs + 7);
    if (rel) {
      f32x16 p0, p1; float mn, alpha; bf16x8 pa0, pa1, pa2, pa3;
      if (MODE == 0) {
        const float dq = (float)(q0w + r32 - 64 * t - 4 * hi);
        if (64 * t + 63 < q0w) { const float k_ = -it.coef * dq, lim = dq - 64.f;
#pragma unroll
          for (int r = 0; r < 16; ++r) { const float c = (float)((r & 3) + 8 * (r >> 2));
            p0[r] = c >= lim ? fmaf(it.coef, c, k_) : -1e30f; p1[r] = c + 32.f >= lim ? fmaf(it.coef, c + 32.f, k_) : -1e30f; } }
        else if (64 * t > q0w + 31) { const float k_ = it.coef * dq, lim = dq + 64.f;
#pragma unroll
          for (int r = 0; r < 16; ++r) { const float c = (float)((r & 3) + 8 * (r >> 2));
            p0[r] = c <= lim ? fmaf(-it.coef, c, k_) : -1e30f; p1[r] = c + 32.f <= lim ? fmaf(-it.coef, c + 32.f, k_) : -1e30f; } }
        else {
#pragma unroll
          for (int r = 0; r < 16; ++r) { const float c = (float)((r & 3) + 8 * (r >> 2)); p0[r] = -it.coef * fabsf(dq - c); p1[r] = -it.coef * fabsf(dq - c - 32.f); } }
        qkt<NQ, false>(p0, p1, K_lds + buf * SHM_K, qr, r32, hi, sub * 128);
      } else {
        qkt<NQ>(p0, p1, K_lds + buf * SHM_K, qr, r32, hi, sub * 128);
        const int dr = t - rq + 7;
        int kb = launder_i(4 * hi - cst);
        const LAS float* trow = tab + dr * 128 + 48 + 15 + 4 * hi - cq;
#pragma unroll
        for (int r = 0; r < 16; ++r) { const int c0 = (r & 3) + 8 * (r >> 2);
          const bool ok0 = (unsigned)(kb + c0) < 16u, ok1 = (unsigned)(kb + c0 + 32) < 16u;
          const float b0 = trow[c0], b1 = trow[c0 + 32];
          p0[r] = ok0 ? p0[r] + b0 : -1e30f; p1[r] = ok1 ? p1[r] + b1 : -1e30f; }
      }
      partialSM<MODE>(p0, p1, m_reg, mn, alpha);
      if (__any(alpha < 1.f)) { if (hi == 0) al_l[r32] = alpha; asm volatile("s_waitcnt lgkmcnt(0)" ::: "memory");
#pragma unroll
        for (int d = 0; d < 4; ++d)
#pragma unroll
          for (int r = 0; r < 16; ++r) o[d][r] *= al_l[crow(r, hi)]; }
      finishSM(p0, p1, alpha, l_reg, pa0, pa1, pa2, pa3); SBAR();
      pv_d0(o, vb0 + buf * SHM_V, pa0, pa1, pa2, pa3);
    }
    if (j + 1 < n_tiles) { if (hf == 0) SWR(sB, 1); else SWR(sA, 0); }
   }
  }
#undef SLD
#undef SWR
  }
#undef SLOAD
#undef SWRITE
  if (hi == 0) li_l[r32] = l_reg;
  asm volatile("s_waitcnt lgkmcnt(0)" ::: "memory");
  float rli[16];
#pragma unroll
  for (int r = 0; r < 16; ++r) rli[r] = __builtin_amdgcn_rcpf(li_l[crow(r, hi)]);
  if (MODE == 0 || MODE == 2) {
#pragma unroll
    for (int r = 0; r < 16; ++r) { const int tok = it.tokbase + (q0w + crow(r, hi)) * it.dil;
      if (MODE == 0) { bf16_t* dst = it.out + (size_t)tok * it.out_ld + it.out_col + r32;
#pragma unroll
        for (int d0 = 0; d0 < 4; ++d0) dst[d0 * 32] = (bf16_t)(cvt_pk_bf16(o[d0][r] * rli[r], 0.f) & 0xffffu); }
      else { unsigned char* dst = (unsigned char*)it.out + (size_t)tok * it.out_ld + it.out_col + r32;
#pragma unroll
        for (int d0 = 0; d0 < 4; ++d0) { const float x = o[d0][r] * rli[r]; dst[d0 * 32] = (unsigned char)(pk4_fp8(x, x, x, x) & 0xffu); } } }
    if (MODE == 0 && hi == 0) { const int tok = it.tokbase + (q0w + r32) * it.dil; it.lse[(size_t)tok * 8 + it.head] = m_reg * SCALE + __logf(l_reg); }
  } else {
    __syncthreads();
    LAS float* ex = (LAS float*)lds + (size_t)(wid & 3) * 4096;
    if (sub == 1) {
#pragma unroll
      for (int d0 = 0; d0 < 4; ++d0)
#pragma unroll
        for (int r = 0; r < 16; ++r) ex[(d0 * 16 + r) * 64 + lane] = o[d0][r] * rli[r] * it.lam;
    }
    __syncthreads();
    if (sub == 0) {
      float ss[16];
#pragma unroll
      for (int r = 0; r < 16; ++r) { float s = 0.f;
#pragma unroll
        for (int d0 = 0; d0 < 4; ++d0) { const float v = o[d0][r] * rli[r] - ex[(d0 * 16 + r) * 64 + lane]; o[d0][r] = v; s += v * v; }
        ss[r] = s; }
#pragma unroll
      for (int r = 0; r < 16; ++r) { float s = ss[r];
s = row_sum16(s); s += shx(s, 16);
        ss[r] = __builtin_amdgcn_rsqf(s * (1.0f / 128.0f) + SUBLN_EPS) * it.outscale; }
      float gcol[4];
#pragma unroll
      for (int d0 = 0; d0 < 4; ++d0) gcol[d0] = it.subg[d0 * 32 + r32];
#pragma unroll
      for (int r = 0; r < 16; ++r) { const int tok = it.tokbase + (q0w + crow(r, hi)) * it.dil; unsigned char* dst = (unsigned char*)it.out + (size_t)tok * it.out_ld + it.out_col + r32;
#pragma unroll
        for (int d0 = 0; d0 < 4; ++d0) { const float x = o[d0][r] * ss[r] * gcol[d0]; dst[d0 * 32] = (unsigned char)(pk4_fp8(x, x, x, x) & 0xffu); } }
    }
  }
}
}

struct Args { const float* in[23]; float* out; unsigned char* ws; int ph_lo, ph_hi; };
enum { I_X = 0, I_C, I_ADAW, I_ADAB, I_GMIX, I_GFFN, I_WIN, I_LQ1, I_LK1, I_LQ2, I_LK2, I_SUBG, I_RPB, I_WOUT, I_RW, I_RB, I_EG, I_EU, I_ED, I_SG, I_SU, I_SD, I_FG };
struct Frame { LAS unsigned char* lds; int tid, lane, wave, vcu, G; };
__device__ __forceinline__ Frame relaunder(const Frame& F0) { Frame F = F0; F.tid = launder_i((int)threadIdx.x); F.lane = F.tid & 63; F.wave = __builtin_amdgcn_readfirstlane(F.tid >> 6); return F; }
constexpr int N_PHASES = 2 + 8 * NLAYER;

__device__ __forceinline__ int gu_row(int j, int type) { return ((j >> 5) << 6) + (type << 5) + (j & 31); }
__device__ __forceinline__ void transpose_item(const float* __restrict__ W, int K, int N, bf16_t* __restrict__ WT, int mode, LAS float* scr, int item, int lane) {
    const int nblk = N >> 5, kb = item / nblk, nb = item - kb * nblk, k0 = 64 * kb, n0 = 32 * nb;
    float v[32];
    const float* src = W + (size_t)(k0 + (lane >> 5)) * N + n0 + (lane & 31);
#pragma unroll
    for (int i = 0; i < 32; ++i) v[i] = src[(size_t)(2 * i) * N];
#pragma unroll
    for (int i = 0; i < 32; ++i) scr[(2 * i + (lane >> 5)) * 33 + (lane & 31)] = v[i];
    LDS_WAIT();
    const int c = lane & 7;
#pragma unroll
    for (int j = 0; j < 4; ++j) { const int n = (lane >> 3) + 8 * j; const LAS float* s = scr + (8 * c) * 33 + n;
        u32x4 o; o.x = cvt_pk_bf16(s[0 * 33], s[1 * 33]); o.y = cvt_pk_bf16(s[2 * 33], s[3 * 33]); o.z = cvt_pk_bf16(s[4 * 33], s[5 * 33]); o.w = cvt_pk_bf16(s[6 * 33], s[7 * 33]);
        const int jn = n0 + n, drow = mode == 0 ? jn : gu_row(jn, mode - 1);
        *(u32x4*)(WT + (size_t)drow * K + k0 + 8 * c) = o; }
    LDS_WAIT();
}
struct CvtItem { const float* src; unsigned char* dst; int K, N, mode, item; };
__device__ __forceinline__ void tf8_load(const CvtItem& c, int lane, f32x4 (&v)[8]) {
    const int nblk = c.N >> 5, kb = c.item / nblk, nb = c.item - kb * nblk, k0 = 64 * kb, n0 = 32 * nb;
    const float* src = c.src + (size_t)(k0 + 8 * (lane >> 3)) * c.N + n0 + 4 * (lane & 7);
#pragma unroll
    for (int i = 0; i < 8; ++i) v[i] = __builtin_nontemporal_load((const f32x4*)(src + (size_t)i * c.N));
}
__device__ __forceinline__ void tf8_store(const CvtItem& c, int lane, LAS float* scr, const f32x4 (&v)[8]) {
    const int nblk = c.N >> 5, kb = c.item / nblk, nb = c.item - kb * nblk, k0 = 64 * kb, n0 = 32 * nb;
    LAS unsigned char* img = (LAS unsigned char*)scr;
    const int kg = lane >> 3, cc = lane & 7;
#pragma unroll
    for (int t = 0; t < 4; ++t) { u32x2 w;
        w.x = pk4_fp8w(v[0][t] * 32.f, v[1][t] * 32.f, v[2][t] * 32.f, v[3][t] * 32.f); w.y = pk4_fp8w(v[4][t] * 32.f, v[5][t] * 32.f, v[6][t] * 32.f, v[7][t] * 32.f);
        *(LAS u32x2*)(img + (4 * cc + t) * 72 + 8 * kg) = w; }
    LDS_WAIT();
    const int n = lane >> 1, kh = (lane & 1) * 32;
    const LAS unsigned char* rp = img + n * 72 + kh;
    const u32x2 a0 = *(const LAS u32x2*)(rp), a1 = *(const LAS u32x2*)(rp + 8), a2 = *(const LAS u32x2*)(rp + 16), a3 = *(const LAS u32x2*)(rp + 24);
    const int jn = n0 + n, drow = c.mode == 0 ? jn : gu_row(jn, c.mode - 1);
    unsigned char* dst = c.dst + (size_t)drow * c.K + k0 + kh;
    u32x4 o0, o1; o0.x = a0.x; o0.y = a0.y; o0.z = a1.x; o0.w = a1.y; o1.x = a2.x; o1.y = a2.y; o1.z = a3.x; o1.w = a3.y;
    *(u32x4*)dst = o0; *(u32x4*)(dst + 16) = o1;
    LDS_WAIT();
}
__device__ __forceinline__ void ph_prologue(const Args& a, const Frame& F0) {
    const Frame F = relaunder(F0);
    unsigned char* ws = a.ws + opq0();
    float* mod = (float*)(ws + WS_MOD);
    LAS float* sc_s = (LAS float*)F.lds;
    LAS float* red = (LAS float*)(F.lds + 32768);
    for (int i = F.tid; i < NBATCH * DM; i += 512) { const float v = a.in[I_C][i]; sc_s[i] = v / (1.0f + __expf(-v)); }
    __syncthreads();
    for (int u = F.vcu; u < NLAYER * 96; u += F.G) {
        const int l = u / 96, n0 = (u % 96) * 128, cg = F.tid & 31, ks = F.tid >> 5;
        const float* W = a.in[I_ADAW] + (size_t)l * DM * MODW + n0 + 4 * cg;
        f32x4 acc[4] = {};
#pragma unroll 16
        for (int it = 0; it < 128; ++it) { const int k = ks + 16 * it; const f32x4 w = __builtin_nontemporal_load((const f32x4*)(W + (size_t)k * MODW));
#pragma unroll
            for (int b = 0; b < 4; ++b) acc[b] += sc_s[b * DM + k] * w; }
#pragma unroll
        for (int b = 0; b < 4; ++b) *(LAS f32x4*)(red + ((ks * 4 + b) * 128 + 4 * cg)) = acc[b];
        __syncthreads();
        { const int b = F.tid >> 7, col = F.tid & 127; float s = 0.f;
#pragma unroll
          for (int k2 = 0; k2 < 16; ++k2) s += red[(k2 * 4 + b) * 128 + col];
          mod[(size_t)(l * 4 + b) * MODW + n0 + col] = s + a.in[I_ADAB][l * MODW + n0 + col]; }
        __syncthreads();
    }
    if (blockIdx.x == 0 && F.tid < NLAYER) { const int l = F.tid; float s1 = 0.f, s2 = 0.f;
        for (int i = 0; i < 64; ++i) { s1 += a.in[I_LQ1][l * 64 + i] * a.in[I_LK1][l * 64 + i]; s2 += a.in[I_LQ2][l * 64 + i] * a.in[I_LK2][l * 64 + i]; }
        const float li = 0.8f - 0.6f * expf(-0.3f * (float)l);
        mod[NLAYER * NBATCH * MODW + l] = expf(s1) - expf(s2) + li; }
    {
        bf16_t* wrh = (bf16_t*)(ws + WS_WRH); bf16_t* wrl = (bf16_t*)(ws + WS_WRL);
        for (int i = F.vcu * 512 + F.tid; i < NLAYER * NE * DM; i += F.G * 512) { const int l = i / (NE * DM), r = i - l * NE * DM, e = r / DM, k = r - e * DM;
            const float w = a.in[I_RW][(size_t)l * DM * NE + (size_t)k * NE + e]; const unsigned hi = cvt_pk_bf16(w, 0.f) & 0xffffu; const float lo = w - __uint_as_float(hi << 16);
            wrh[i] = (bf16_t)hi; wrl[i] = (bf16_t)(cvt_pk_bf16(lo, 0.f) & 0xffffu); }
    }
    __syncthreads();
    LAS float* scr = (LAS float*)(F.lds + F.wave * 16384);
    const int gw = F.vcu * 8 + F.wave, NGW = F.G * 8;
    constexpr int I_IN = 32 * 192;
    for (int it = gw; it < I_IN; it += 3 * NGW) {
        CvtItem c0, c1, c2; c0.src = c1.src = c2.src = a.in[I_WIN]; c0.dst = c1.dst = c2.dst = (unsigned char*)(ws + WS_WIN); c0.K = c1.K = c2.K = DM; c0.N = c1.N = c2.N = QKVW; c0.mode = c1.mode = c2.mode = 0;
        const bool h1 = it + NGW < I_IN, h2 = it + 2 * NGW < I_IN;
        c0.item = it; c1.item = h1 ? it + NGW : it; c2.item = h2 ? it + 2 * NGW : it;
        f32x4 v0[8], v1[8], v2[8]; tf8_load(c0, F.lane, v0); tf8_load(c1, F.lane, v1); tf8_load(c2, F.lane, v2);
        tf8_store(c0, F.lane, scr, v0); tf8_store(c1, F.lane, scr, v1); tf8_store(c2, F.lane, scr, v2);
    }
}
constexpr int CONV_ITEMS = 3 * NEX * 512, CONV_CHUNK = 64, CONV_NCHUNK = (CONV_ITEMS + CONV_CHUNK - 1) / CONV_CHUNK;
constexpr int CONV_XOUT = 32 * 64, CONV_XIN = 32 * 192, CONV_EXTRA = 2 * CONV_XOUT + CONV_XIN;
constexpr int CONV_NCHUNK0 = (CONV_ITEMS + CONV_EXTRA + CONV_CHUNK - 1) / CONV_CHUNK;
__device__ __forceinline__ CvtItem conv_expert_desc(const Args& a, int l, int r) {
    unsigned char* ws = a.ws; constexpr int I_E = 512; CvtItem c;
    const int total = CONV_ITEMS + (l == 0 ? CONV_EXTRA : 0);
    if (r >= total) r = total - 1;
    if (r >= CONV_ITEMS) {
        r -= CONV_ITEMS; c.K = DM; c.mode = 0;
        if (r < CONV_XOUT) { c.src = a.in[I_WOUT]; c.dst = (unsigned char*)(ws + WS_WOUT); c.N = DM; c.item = r; return c; } r -= CONV_XOUT;
        if (r < CONV_XIN) { c.src = a.in[I_WIN] + (size_t)DM * QKVW; c.dst = (unsigned char*)(ws + WS_WIN) + (size_t)QKVW * DM; c.N = QKVW; c.item = r; return c; } r -= CONV_XIN;
        c.src = a.in[I_WOUT] + (size_t)DM * DM; c.dst = (unsigned char*)(ws + WS_WOUT) + (size_t)DM * DM; c.N = DM; c.item = r; return c;
    }
    const int seg = r / (NEX * I_E); r -= seg * NEX * I_E; const int e = r / I_E; c.item = r - e * I_E;
    if (seg < 2) { c.src = e < NE ? a.in[seg == 0 ? I_EG : I_EU] + (size_t)(l * NE + e) * DM * EDIM : a.in[seg == 0 ? I_SG : I_SU] + (size_t)l * DM * EDIM;
        c.K = DM; c.N = EDIM; c.dst = (unsigned char*)(ws + WS_WGU) + (size_t)(l * NEX + e) * 1024 * DM; c.mode = 1 + seg; }
    else { c.src = e < NE ? a.in[I_ED] + (size_t)(l * NE + e) * EDIM * DM : a.in[I_SD] + (size_t)l * EDIM * DM;
        c.K = EDIM; c.N = DM; c.dst = (unsigned char*)(ws + WS_WD) + (size_t)(l * NEX + e) * DM * EDIM; c.mode = 0; }
    return c;
}
__device__ __forceinline__ int queue_pull(unsigned* q, volatile LAS int* slot, int tid) {
    if (tid == 0) *slot = (int)xb_add(q, 1u);
    __syncthreads();
    const int v = *slot;
    __syncthreads();
    return v;
}

__device__ __forceinline__ void ph_norm(const Frame& F0, const float* __restrict__ src, const float* __restrict__ gvec, const float* __restrict__ modl, int sh_off, int sc_off, bf16_t* __restrict__ dst) {
    const Frame F = relaunder(F0);
    const int gw = F.vcu * 8 + F.wave, NGW = F.G * 8;
    for (int chunk = gw; chunk < NTOK / 8; chunk += NGW) {
        const int row0 = chunk * 8, b = row0 / SEQ;
        f32x4 Gv[8], Sv[8];
#pragma unroll
        for (int j = 0; j < 8; ++j) { const int col = 4 * F.lane + 256 * j; const f32x4 g4 = *(const f32x4*)(gvec + col), s4 = *(const f32x4*)(modl + (size_t)b * MODW + sc_off + col);
            Gv[j] = g4 * (1.0f + s4); Sv[j] = *(const f32x4*)(modl + (size_t)b * MODW + sh_off + col); }
        f32x4 nx[8];
#pragma unroll
        for (int j = 0; j < 8; ++j) nx[j] = *(const f32x4*)(src + (size_t)row0 * DM + 4 * F.lane + 256 * j);
        for (int rr = 0; rr < 8; ++rr) {
            const float* xr = src + (size_t)(row0 + rr + (rr < 7 ? 1 : 0)) * DM + 4 * F.lane;
            f32x4 v[8]; float ss = 0.f;
#pragma unroll
            for (int j = 0; j < 8; ++j) { v[j] = nx[j]; nx[j] = *(const f32x4*)(xr + 256 * j); ss += (v[j].x * v[j].x + v[j].y * v[j].y) + (v[j].z * v[j].z + v[j].w * v[j].w); }
            const float rstd = __builtin_amdgcn_rsqf(wave_sum(ss) * (1.0f / DM) + NORM_EPS);
            unsigned char* orow = (unsigned char*)dst + (size_t)(row0 + rr) * DM + 4 * F.lane;
#pragma unroll
            for (int j = 0; j < 8; ++j) { const f32x4 h = v[j] * rstd * Gv[j] + Sv[j]; *(unsigned*)(orow + 256 * j) = pk4_fp8(h.x, h.y, h.z, h.w); }
        }
    }
}

__device__ __forceinline__ void ph_attention1(const Args& a, const Frame& F0, int l, int qrep = 0) {
    const Frame F = relaunder(F0);
    unsigned char* ws = a.ws + opq0();
    const bf16_t* qkv = (const bf16_t*)(ws + WS_QKV);
    unsigned* ctl = (unsigned*)(ws + WS_CTL);
    LAS char* lds = (LAS char*)F.lds;
    {
        LAS unsigned* kmx = (LAS unsigned*)(F.lds + att::RNG_OFF + 64);
        for (int chunk = F.vcu; chunk < NTOK / 64; chunk += F.G) {
            if (F.tid < 8) kmx[F.tid] = 0u;
            __syncthreads();
            const int tl = F.tid >> 3, part = F.tid & 7, tok = chunk * 64 + tl, b = tok / SEQ;
            const bf16_t* kp = qkv + (size_t)tok * QKVW + DM + (8 + (part >> 1)) * HD + (part & 1) * 64;
            float ss = 0.f;
#pragma unroll
            for (int i = 0; i < 8; ++i) { const u32x4 x = *(const u32x4*)(kp + 8 * i);
                ss += bflo(x.x) * bflo(x.x) + bfhi(x.x) * bfhi(x.x) + bflo(x.y) * bflo(x.y) + bfhi(x.y) * bfhi(x.y) + bflo(x.z) * bflo(x.z) + bfhi(x.z) * bfhi(x.z) + bflo(x.w) * bflo(x.w) + bfhi(x.w) * bfhi(x.w); }
            __hip_atomic_fetch_max(&kmx[part], __float_as_uint(ss), __ATOMIC_RELAXED, __HIP_MEMORY_SCOPE_WORKGROUP);
            __syncthreads();
            if (F.tid < 8) __hip_atomic_fetch_max(ctl + CW_KMAX + ((l * NBATCH + b) * 4 + (F.tid >> 1)) * 2 + (F.tid & 1), kmx[F.tid], __ATOMIC_RELAXED, __HIP_MEMORY_SCOPE_AGENT);
            __syncthreads();
        }
    }
    volatile LAS int* qslot = (volatile LAS int*)(F.lds + MISC_OFF + 16);
    const bool conv_first = (F.vcu & 7) < 4;
    for (int pass = 0; pass < 2; ++pass) {
        if ((pass == 0) == conv_first) {
            LAS float* scr = (LAS float*)(F.lds + F.wave * 16384);
            for (;;) {
                const int c = queue_pull(ctl + CW_QV + 64 * l + 8 * qrep, qslot, F.tid);
                if (c >= (l == 0 ? CONV_NCHUNK0 : CONV_NCHUNK)) break;
                const int r0 = c * CONV_CHUNK + F.wave * (CONV_CHUNK / 8);
                f32x4 va[8], vb[8], vc[8], vd[8];
                int NI = CONV_CHUNK / 8; asm volatile("" : "+s"(NI));
#define CV_LOAD(k, V) tf8_load(conv_expert_desc(a, l, r0 + (k)), F.lane, V)
#define CV_STORE(k, V) tf8_store(conv_expert_desc(a, l, r0 + (k)), F.lane, scr, V)
                CV_LOAD(0, va); CV_LOAD(1, vb); CV_LOAD(2, vc);
#pragma unroll 1
                for (int k = 0; k < NI; k += 4) {
                    CV_LOAD(k + 3, vd); CV_STORE(k, va);
                    if (k + 4 < NI) CV_LOAD(k + 4, va); CV_STORE(k + 1, vb);
                    if (k + 5 < NI) CV_LOAD(k + 5, vb); CV_STORE(k + 2, vc);
                    if (k + 6 < NI) CV_LOAD(k + 6, vc); CV_STORE(k + 3, vd);
                }
#undef CV_LOAD
#undef CV_STORE
            }
        } else {
            for (;;) {
                const int idx = queue_pull(ctl + CW_QC2 + 64 * l + 8 * qrep, qslot, F.tid);
                if (idx >= 256) break;
                const int b = idx >> 6, h = (idx >> 4) & 3, qb = idx & 15;
                att::Item it{}; it.qkv = qkv; it.tokbase = b * SEQ; it.dil = 1; it.q0 = 256 * qb; it.head = 12 + h;
                int t0 = 4 * qb - 4; t0 = t0 < 0 ? 0 : (t0 > 56 ? 56 : t0); int te = 4 * qb + 3 - 4; te = te < 0 ? 0 : (te > 56 ? 56 : te); te += 7;
                it.t0 = t0; it.nt = te - t0 + 1; it.coef = 0.f;
                it.out = (bf16_t*)(ws + WS_OCAT); it.out_ld = DM; it.out_col = (12 + h) * HD; it.lse = nullptr;
                it.lam = 0.f; it.outscale = 0.f; it.subg = nullptr; it.rpb = a.in[I_RPB] + (size_t)(l * 4 + h) * 15 * 31;
                att::attn_item<2>(it, lds);
            }
            for (;;) {
                const int idx = queue_pull(ctl + CW_QA + 64 * l + 8 * qrep, qslot, F.tid);
                if (idx >= 1536) break;
                const int bh = idx / 48, w = idx - bh * 48, b = bh >> 3, h = bh & 7, p = w >> 4, v = w & 15;
                const int dil = 1 << (2 * p), Lv = SEQ / dil;
                int res, qb; if (p == 0) { res = 0; qb = v; } else if (p == 1) { res = v >> 2; qb = v & 3; } else { res = v; qb = 0; }
                att::Item it{}; it.qkv = qkv; it.tokbase = b * SEQ + res; it.dil = dil; it.q0 = 256 * qb; it.head = h;
                int t0 = 4 * qb - 1; if (t0 < 0) t0 = 0; int te = 4 * qb + 4; if (te > Lv / 64 - 1) te = Lv / 64 - 1;
                it.t0 = t0; it.nt = te - t0 + 1;
                it.coef = exp2f(-(float)(h + 1)) * (float)dil * (1.0f / 0.088388347648318440f);
                it.out = (bf16_t*)(ws + WS_APART) + (size_t)p * NTOK * 1024; it.out_ld = 1024; it.out_col = h * HD; it.lse = (float*)(ws + WS_ALSE) + (size_t)p * NTOK * 8;
                it.lam = 0.f; it.outscale = 0.f; it.subg = nullptr; it.rpb = nullptr;
                att::attn_item<0>(it, lds);
            }
        }
    }
}
__device__ __forceinline__ void ph_acombine(const Args& a, const Frame& F0, int tok0, int tend) {
    const Frame F = relaunder(F0);
    unsigned char* ws = a.ws + opq0(); const bf16_t* ap = (const bf16_t*)(ws + WS_APART); const float* lse = (const float*)(ws + WS_ALSE); bf16_t* ocat = (bf16_t*)(ws + WS_OCAT);
    const int gw = tok0, h = F.lane >> 3, c0 = (F.lane & 7) * 16;
    float nlv[3]; u32x4 nx[3][2];
#pragma unroll
    for (int p = 0; p < 3; ++p) { nlv[p] = lse[((size_t)p * NTOK + gw) * 8 + h]; const bf16_t* src = ap + ((size_t)p * NTOK + gw) * 1024 + h * HD + c0; nx[p][0] = *(const u32x4*)src; nx[p][1] = *(const u32x4*)(src + 8); }
    for (int tok = gw; tok < tend; ++tok) {
        float lv[3]; u32x4 xv[3][2]; const int tn = tok + 1 < tend ? tok + 1 : tok;
#pragma unroll
        for (int p = 0; p < 3; ++p) { lv[p] = nlv[p]; xv[p][0] = nx[p][0]; xv[p][1] = nx[p][1];
            nlv[p] = lse[((size_t)p * NTOK + tn) * 8 + h]; const bf16_t* src = ap + ((size_t)p * NTOK + tn) * 1024 + h * HD + c0; nx[p][0] = *(const u32x4*)src; nx[p][1] = *(const u32x4*)(src + 8); }
        const float m = fmaxf(lv[0], fmaxf(lv[1], lv[2]));
        float w[3]; float s = 0.f;
#pragma unroll
        for (int p = 0; p < 3; ++p) { w[p] = __expf(lv[p] - m); s += w[p]; }
        const float inv = 1.0f / s;
        float acc[16] = {};
#pragma unroll
        for (int p = 0; p < 3; ++p) { const float wp = w[p] * inv;
#pragma unroll
            for (int q = 0; q < 2; ++q) { const u32x4 x = xv[p][q];
                acc[8 * q + 0] += wp * bflo(x.x); acc[8 * q + 1] += wp * bfhi(x.x); acc[8 * q + 2] += wp * bflo(x.y); acc[8 * q + 3] += wp * bfhi(x.y);
                acc[8 * q + 4] += wp * bflo(x.z); acc[8 * q + 5] += wp * bfhi(x.z); acc[8 * q + 6] += wp * bflo(x.w); acc[8 * q + 7] += wp * bfhi(x.w); } }
        unsigned char* dst = (unsigned char*)ocat + (size_t)tok * DM + h * HD + c0;
        u32x4 o; o.x = pk4_fp8(acc[0], acc[1], acc[2], acc[3]); o.y = pk4_fp8(acc[4], acc[5], acc[6], acc[7]); o.z = pk4_fp8(acc[8], acc[9], acc[10], acc[11]); o.w = pk4_fp8(acc[12], acc[13], acc[14], acc[15]);
        *(u32x4*)dst = o;
    }
}
__device__ __forceinline__ void ph_attention2(const Args& a, const Frame& F0, int l, int qrep = 0) {
    const Frame F = relaunder(F0);
    unsigned char* ws = a.ws + opq0();
    const bf16_t* qkv = (const bf16_t*)(ws + WS_QKV);
    const float* mod = (const float*)(ws + WS_MOD);
    unsigned* ctl = (unsigned*)(ws + WS_CTL);
    LAS char* lds = (LAS char*)F.lds;
    volatile LAS int* qslot = (volatile LAS int*)(F.lds + MISC_OFF + 16);
    for (;;) {
        if (F.tid == 0) *qslot = (int)xb_add(ctl + CW_QB + 64 * l + 8 * qrep, 1u);
        __syncthreads();
        const int qi = *qslot;
        if (qi >= 512) break;
        const int h = 3 - (qi >> 7), b = (qi >> 5) & 3, qb = qi & 31;
        att::Item it{}; it.qkv = qkv; it.tokbase = b * SEQ; it.dil = 1; it.q0 = 128 * qb; it.head = 8 + h; it.t0 = 0; it.nt = SEQ / 64;
        it.coef = exp2f(-(0.5f + (float)h)) * 8.0f;
        it.out = (bf16_t*)(ws + WS_OCAT); it.out_ld = DM; it.out_col = (8 + h) * HD; it.lse = nullptr;
        it.lam = mod[NLAYER * NBATCH * MODW + l]; it.outscale = 1.0f - (0.8f - 0.6f * expf(-0.3f * (float)l)); it.subg = a.in[I_SUBG] + l * HD; it.rpb = nullptr;
        it.kmax2a = __uint_as_float(xb_ld(ctl + CW_KMAX + ((l * NBATCH + b) * 4 + h) * 2 + 0)); it.kmax2b = __uint_as_float(xb_ld(ctl + CW_KMAX + ((l * NBATCH + b) * 4 + h) * 2 + 1));
        att::attn_item<1>(it, lds);
    }
    __syncthreads();
    for (;;) {
        const int c = queue_pull(ctl + CW_QM + 64 * l + 8 * qrep, qslot, F.tid);
        if (c >= NTOK / 64) break;
        ph_acombine(a, F0, c * 64 + F.wave * 8, c * 64 + F.wave * 8 + 8);
    }
}
__device__ __forceinline__ void ph_router(const Args& a, const Frame& F0, int l) {
    const Frame F = relaunder(F0);
    unsigned char* ws = a.ws + opq0();
    const bf16_t* x1 = (const bf16_t*)(ws + WS_XA); unsigned char* hb = (unsigned char*)(ws + WS_H);
    const float* modl = (const float*)(ws + WS_MOD) + (size_t)l * NBATCH * MODW;
    const float* gffn = a.in[I_GFFN] + l * DM; const float* Wr = a.in[I_RW] + (size_t)l * DM * NE; const float* rbias = a.in[I_RB] + l * NE;
    unsigned* gcount = (unsigned*)(ws + WS_CTL) + CW_CNT + l * NE;
    int* toklist = (int*)(ws + WS_TOK); int* slot_er = (int*)(ws + WS_SLOT); float* slot_gate = (float*)(ws + WS_SLOT + 512 * 1024);
    LAS float* part = (LAS float*)F.lds;
    LAS float* logit = (LAS float*)(F.lds + 65536);
    LAS float* rstd_s = (LAS float*)(F.lds + 81920);
    LAS int* hist = (LAS int*)(F.lds + 81920 + 256);
    LAS int* basee = (LAS int*)(F.lds + 81920 + 512);
    LAS int* sl_e = (LAS int*)(F.lds + 81920 + 1024);
    LAS int* sl_lr = (LAS int*)(F.lds + 81920 + 1024 + 2048);
    LAS float* sl_g = (LAS float*)(F.lds + 81920 + 1024 + 4096);
    LAS float* gvl = (LAS float*)(F.lds + 98304);
    LAS float* svl = (LAS float*)(F.lds + 106496);
    const int lane = F.lane, wid = F.wave;
    for (int unit = F.vcu; unit < NTOK / 64; unit += F.G) {
        const int tok0 = unit * 64, b = tok0 / SEQ;
        const float* sc2 = modl + (size_t)b * MODW + 4 * DM; const float* sh2 = modl + (size_t)b * MODW + 3 * DM;
        if (F.tid < 64) hist[F.tid] = 0;
        {
            f32x4 Gv[8], Sv[8];
#pragma unroll
            for (int j = 0; j < 8; ++j) { const int col = 4 * lane + 256 * j; Gv[j] = *(const f32x4*)(gffn + col) * (1.0f + *(const f32x4*)(sc2 + col)); Sv[j] = *(const f32x4*)(sh2 + col);
                if (wid == j) { *(LAS f32x4*)(gvl + col) = Gv[j]; *(LAS f32x4*)(svl + col) = Sv[j]; } }
            u32x2 nx[8];
            { const bf16_t* xr = x1 + (size_t)(tok0 + 8 * wid) * DM + 4 * lane;
#pragma unroll
              for (int j = 0; j < 8; ++j) nx[j] = *(const u32x2*)(xr + 256 * j); }
            for (int rr = 0; rr < 8; ++rr) { const int row = tok0 + 8 * wid + rr;
                const bf16_t* xr = x1 + (size_t)(row + (rr < 7 ? 1 : 0)) * DM + 4 * lane; f32x4 v[8]; float ss = 0.f;
#pragma unroll
                for (int j = 0; j < 8; ++j) { const u32x2 xw = nx[j]; nx[j] = *(const u32x2*)(xr + 256 * j);
                    v[j].x = bflo(xw.x); v[j].y = bfhi(xw.x); v[j].z = bflo(xw.y); v[j].w = bfhi(xw.y);
                    ss += (v[j].x * v[j].x + v[j].y * v[j].y) + (v[j].z * v[j].z + v[j].w * v[j].w); }
                const float rstd = __builtin_amdgcn_rsqf(wave_sum(ss) * (1.0f / DM) + NORM_EPS);
                if (lane == 0) rstd_s[8 * wid + rr] = rstd;
                unsigned char* orow = hb + (size_t)row * DM + 4 * lane;
#pragma unroll
                for (int j = 0; j < 8; ++j) { const f32x4 h = v[j] * rstd * Gv[j] + Sv[j]; *(unsigned*)(orow + 256 * j) = pk4_fp8(h.x, h.y, h.z, h.w); } }
        }
        __syncthreads();
        {
            const int th = wid & 1, kq = wid >> 1, r = lane & 31, g = lane >> 5;
            const float rs = rstd_s[32 * th + r];
            const bf16_t* xr = x1 + (size_t)(tok0 + 32 * th + r) * DM;
            const bf16_t* wh0 = (const bf16_t*)(ws + WS_WRH) + ((size_t)l * NE + r) * DM; const bf16_t* wl0 = (const bf16_t*)(ws + WS_WRL) + ((size_t)l * NE + r) * DM;
            f32x16 acc0 = {}, acc1 = {};
#pragma unroll 4
            for (int s = 0; s < 32; ++s) { const int k = 512 * kq + 16 * s + 8 * g;
                const u32x4 xw = *(const u32x4*)(xr + k);
                float hv[8] = {bflo(xw.x), bfhi(xw.x), bflo(xw.y), bfhi(xw.y), bflo(xw.z), bfhi(xw.z), bflo(xw.w), bfhi(xw.w)};
#pragma unroll
                for (int q = 0; q < 2; ++q) { const f32x4 g4 = *(const LAS f32x4*)(gvl + k + 4 * q); const f32x4 s4 = *(const LAS f32x4*)(svl + k + 4 * q);
#pragma unroll
                    for (int t = 0; t < 4; ++t) hv[4 * q + t] = hv[4 * q + t] * rs * g4[t] + s4[t]; }
                u32x4 ah, al;
#pragma unroll
                for (int q = 0; q < 4; ++q) { const unsigned hp = cvt_pk_bf16(hv[2 * q], hv[2 * q + 1]); const float l0 = hv[2 * q] - bflo(hp), l1 = hv[2 * q + 1] - bfhi(hp); ah[q] = hp; al[q] = cvt_pk_bf16(l0, l1); }
                const bf16x8 Ah = __builtin_bit_cast(bf16x8, ah), Al = __builtin_bit_cast(bf16x8, al);
                const bf16x8 Bh0 = *(const bf16x8*)(wh0 + k), Bl0 = *(const bf16x8*)(wl0 + k), Bh1 = *(const bf16x8*)(wh0 + (size_t)32 * DM + k), Bl1 = *(const bf16x8*)(wl0 + (size_t)32 * DM + k);
                acc0 = __builtin_amdgcn_mfma_f32_32x32x16_bf16(Ah, Bh0, acc0, 0, 0, 0); acc1 = __builtin_amdgcn_mfma_f32_32x32x16_bf16(Ah, Bh1, acc1, 0, 0, 0);
                acc0 = __builtin_amdgcn_mfma_f32_32x32x16_bf16(Ah, Bl0, acc0, 0, 0, 0); acc1 = __builtin_amdgcn_mfma_f32_32x32x16_bf16(Ah, Bl1, acc1, 0, 0, 0);
                acc0 = __builtin_amdgcn_mfma_f32_32x32x16_bf16(Al, Bh0, acc0, 0, 0, 0); acc1 = __builtin_amdgcn_mfma_f32_32x32x16_bf16(Al, Bh1, acc1, 0, 0, 0); }
#pragma unroll
            for (int i = 0; i < 16; ++i) { const int tl = 32 * th + (i & 3) + 8 * (i >> 2) + 4 * g;
                part[(kq * 64 + tl) * 64 + r] = acc0[i]; part[(kq * 64 + tl) * 64 + 32 + r] = acc1[i]; }
        }
        __syncthreads();
#pragma unroll
        for (int i = 0; i < 8; ++i) { const int o = F.tid + 512 * i; logit[o] = (part[o] + part[4096 + o]) + (part[8192 + o] + part[12288 + o]); }
        __syncthreads();
        for (int tt = 0; tt < 8; ++tt) { const int tl = 8 * wid + tt;
            const float lg = logit[tl * 64 + lane]; const float sgm = 1.0f / (1.0f + __expf(-lg)); const float sel = sgm + rbias[lane];
            const float m1 = gmax8(sel);
            const int i1 = gmin8((sel == m1) ? lane : 64);
            const float m2 = gmax8((lane == i1) ? -3.0e38f : sel);
            const float gs = m1 + m2; const int myg = lane >> 3; int gr = 0;
#pragma unroll
            for (int g2 = 0; g2 < 8; ++g2) { const float og = rdl(gs, g2 * 8); gr += (og > gs || (og == gs && g2 < myg)) ? 1 : 0; }
            const float selm = gr < 4 ? sel : -1e30f; int rank = 0;
#pragma unroll 8
            for (int e2 = 0; e2 < 64; ++e2) { const float os = rdl(selm, e2); rank += (os > selm || (os == selm && e2 < lane)) ? 1 : 0; }
            const bool chosen = rank < TOPK;
            const float ssum = wave_sum(chosen ? sgm : 0.f);
            if (chosen) { const int lr = __hip_atomic_fetch_add(&hist[lane], 1, __ATOMIC_RELAXED, __HIP_MEMORY_SCOPE_WORKGROUP); sl_e[tl * 8 + rank] = lane; sl_lr[tl * 8 + rank] = lr; sl_g[tl * 8 + rank] = sgm / ssum * 2.5f; }
        }
        __syncthreads();
        if (F.tid < 64) { const int hc = hist[F.tid]; basee[F.tid] = hc > 0 ? (int)xb_add(gcount + F.tid, (unsigned)hc) : 0; }
        __syncthreads();
        { const int tl = F.tid >> 3, sl = F.tid & 7, e = sl_e[tl * 8 + sl], rank = basee[e] + sl_lr[tl * 8 + sl], tok = tok0 + tl;
          toklist[(size_t)e * NTOK + rank] = tok; slot_er[(size_t)tok * 8 + sl] = e * NTOK + rank; slot_gate[(size_t)tok * 8 + sl] = sl_g[tl * 8 + sl]; }
        __syncthreads();
    }
}
__device__ __forceinline__ void moe_tables(const Args& a, const Frame& F0, int l) {
    const Frame F = relaunder(F0);
    LAS int* bs = (LAS int*)(F.lds + TAB_BS_OFF); LAS int* cn = (LAS int*)(F.lds + TAB_CNT_OFF);
    unsigned* gcount = (unsigned*)(a.ws + WS_CTL) + CW_CNT + l * NE;
    if (F.tid < NE) cn[F.tid] = (int)xb_ld(gcount + F.tid);
    if (F.tid == NE) cn[NE] = NTOK;
    __syncthreads();
    if (F.tid == 0) { int acc = 0; for (int e = 0; e < NEX; ++e) { bs[e] = acc; acc += (cn[e] + 255) >> 8; } bs[NEX] = acc; }
    __syncthreads();
}
__device__ __forceinline__ void ph_combine(const Args& a, const Frame& F0, int l) {
    const Frame F = relaunder(F0);
    unsigned char* ws = a.ws + opq0();
    const LAS int* bs = (const LAS int*)(F.lds + TAB_BS_OFF);
    const bf16_t* x1 = (const bf16_t*)(ws + WS_XA); bf16_t* x2 = (bf16_t*)(ws + WS_XB); bf16_t* hb = (bf16_t*)(ws + WS_H);
    const unsigned char* yb = (const unsigned char*)(ws + WS_YBUF);
    const int* slot_er = (const int*)(ws + WS_SLOT); const float* slot_gate = (const float*)(ws + WS_SLOT + 512 * 1024);
    const float* modl = (const float*)(ws + WS_MOD) + (size_t)l * NBATCH * MODW;
    const bool last = (l == NLAYER - 1);
    const float* modn = (const float*)(ws + WS_MOD) + (size_t)(last ? l : l + 1) * NBATCH * MODW;
    const float* gnext = last ? a.in[I_FG] : a.in[I_GMIX] + (l + 1) * DM;
    const int gw = F.vcu * 8 + F.wave, NGW = F.G * 8, lane = F.lane;
    const int shbase = bs[NE] * 256;
    LAS float* const T = (LAS float*)F.lds;
    {
        const int col = 4 * F.tid;
        const f32x4 gn = *(const f32x4*)(gnext + col);
#pragma unroll
        for (int b = 0; b < NBATCH; ++b) {
            const f32x4 g2 = *(const f32x4*)(modl + (size_t)b * MODW + 5 * DM + col);
            f32x4 gv = gn, hv4 = (f32x4){0.f, 0.f, 0.f, 0.f};
            if (!last) { const f32x4 s4 = *(const f32x4*)(modn + (size_t)b * MODW + 1 * DM + col); hv4 = *(const f32x4*)(modn + (size_t)b * MODW + col);
                gv.x = gn.x * (1.0f + s4.x); gv.y = gn.y * (1.0f + s4.y); gv.z = gn.z * (1.0f + s4.z); gv.w = gn.w * (1.0f + s4.w); }
            *(LAS f32x4*)(T + (b * 3 + 0) * DM + col) = g2; *(LAS f32x4*)(T + (b * 3 + 1) * DM + col) = gv; *(LAS f32x4*)(T + (b * 3 + 2) * DM + col) = hv4; }
    }
    __syncthreads();
    int er_n = slot_er[(size_t)gw * 8 + (lane & 7)]; float gt_n = slot_gate[(size_t)gw * 8 + (lane & 7)];
    for (int tok = gw; tok < NTOK; tok += NGW) {
        const int b = tok / SEQ;
        const int er = er_n; const float gt = gt_n;
        { const int tn = tok + NGW < NTOK ? tok + NGW : tok; er_n = slot_er[(size_t)tn * 8 + (lane & 7)]; gt_n = slot_gate[(size_t)tn * 8 + (lane & 7)]; }
        u32x4 xw[2][2];
#pragma unroll
        for (int j = 0; j < 2; ++j)
#pragma unroll
            for (int hq = 0; hq < 2; ++hq) xw[j][hq] = *(const u32x4*)(x1 + (size_t)tok * DM + 16 * lane + 1024 * j + 8 * hq);
        float acc[2][16];
#pragma unroll
        for (int j = 0; j < 2; ++j)
#pragma unroll
            for (int t = 0; t < 16; ++t) acc[j][t] = 0.f;
#pragma unroll
        for (int s = 0; s < 9; ++s) {
            int pos; float g;
            if (s < 8) { const int ers = shf(er, s); g = shf(gt, s); pos = bs[ers >> 14] * 256 + (ers & (NTOK - 1)); } else { pos = shbase + tok; g = 1.0f; }
            const unsigned char* yr = yb + (size_t)pos * DM + 16 * lane;
#pragma unroll
            for (int j = 0; j < 2; ++j) { const u32x4 y = *(const u32x4*)(yr + 1024 * j);
#pragma unroll
                for (int q = 0; q < 4; ++q) { const f32x2 lo = __builtin_amdgcn_cvt_pk_f32_fp8((int)y[q], false), hi = __builtin_amdgcn_cvt_pk_f32_fp8((int)y[q], true);
                    acc[j][4 * q + 0] += g * lo.x; acc[j][4 * q + 1] += g * lo.y; acc[j][4 * q + 2] += g * hi.x; acc[j][4 * q + 3] += g * hi.y; } }
        }
        const LAS float* Tb = T + b * 3 * DM + 16 * lane;
        float ss = 0.f;
#pragma unroll
        for (int j = 0; j < 2; ++j) { const int col = 16 * lane + 1024 * j;
#pragma unroll
            for (int hq = 0; hq < 2; ++hq) { const u32x4 w = xw[j][hq];
#pragma unroll
                for (int q = 0; q < 2; ++q) { const f32x4 g2 = *(const LAS f32x4*)(Tb + 1024 * j + 8 * hq + 4 * q); const int t = 8 * hq + 4 * q;
                    const float r0 = bflo(w[2 * q]) + g2.x * acc[j][t], r1 = bfhi(w[2 * q]) + g2.y * acc[j][t + 1], r2 = bflo(w[2 * q + 1]) + g2.z * acc[j][t + 2], r3 = bfhi(w[2 * q + 1]) + g2.w * acc[j][t + 3];
                    acc[j][t] = r0; acc[j][t + 1] = r1; acc[j][t + 2] = r2; acc[j][t + 3] = r3; ss += (r0 * r0 + r1 * r1) + (r2 * r2 + r3 * r3); } }
            if (!last) { u32x4 o0, o1; o0.x = cvt_pk_bf16(acc[j][0], acc[j][1]); o0.y = cvt_pk_bf16(acc[j][2], acc[j][3]); o0.z = cvt_pk_bf16(acc[j][4], acc[j][5]); o0.w = cvt_pk_bf16(acc[j][6], acc[j][7]);
                o1.x = cvt_pk_bf16(acc[j][8], acc[j][9]); o1.y = cvt_pk_bf16(acc[j][10], acc[j][11]); o1.z = cvt_pk_bf16(acc[j][12], acc[j][13]); o1.w = cvt_pk_bf16(acc[j][14], acc[j][15]);
                *(u32x4*)(x2 + (size_t)tok * DM + col) = o0; *(u32x4*)(x2 + (size_t)tok * DM + col + 8) = o1; } }
        const float rstd = __builtin_amdgcn_rsqf(wave_sum(ss) * (1.0f / DM) + NORM_EPS);
#pragma unroll
        for (int j = 0; j < 2; ++j) { const int col = 16 * lane + 1024 * j;
            if (last) {
#pragma unroll
                for (int q = 0; q < 4; ++q) { const f32x4 g4 = *(const LAS f32x4*)(Tb + DM + 1024 * j + 4 * q); f32x4 o; o.x = acc[j][4 * q + 0] * rstd * g4.x; o.y = acc[j][4 * q + 1] * rstd * g4.y; o.z = acc[j][4 * q + 2] * rstd * g4.z; o.w = acc[j][4 * q + 3] * rstd * g4.w;
                    *(f32x4*)(a.out + (size_t)tok * DM + col + 4 * q) = o; }
            } else {
                float hv[16];
#pragma unroll
                for (int q = 0; q < 4; ++q) { const f32x4 g4 = *(const LAS f32x4*)(Tb + DM + 1024 * j + 4 * q), h4 = *(const LAS f32x4*)(Tb + 2 * DM + 1024 * j + 4 * q);
                    hv[4 * q + 0] = acc[j][4 * q + 0] * rstd * g4.x + h4.x; hv[4 * q + 1] = acc[j][4 * q + 1] * rstd * g4.y + h4.y;
                    hv[4 * q + 2] = acc[j][4 * q + 2] * rstd * g4.z + h4.z; hv[4 * q + 3] = acc[j][4 * q + 3] * rstd * g4.w + h4.w; }
                u32x4 o0; o0.x = pk4_fp8(hv[0], hv[1], hv[2], hv[3]); o0.y = pk4_fp8(hv[4], hv[5], hv[6], hv[7]); o0.z = pk4_fp8(hv[8], hv[9], hv[10], hv[11]); o0.w = pk4_fp8(hv[12], hv[13], hv[14], hv[15]);
                *(u32x4*)((unsigned char*)hb + (size_t)tok * DM + col) = o0;
            }
        }
    }
}

__global__ void __launch_bounds__(512, 2) fwd_kernel(Args args) {
    extern __shared__ __attribute__((aligned(16))) unsigned char lds_raw[];
    Frame F; F.lds = (LAS unsigned char*)lds_raw; F.tid = threadIdx.x; F.lane = F.tid & 63; F.wave = __builtin_amdgcn_readfirstlane(F.tid >> 6);
    F.G = gridDim.x; { const int bx = blockIdx.x; F.vcu = (F.G % 8 == 0) ? (bx % 8) * (F.G / 8) + bx / 8 : bx; }
    unsigned char* ws = args.ws;
    unsigned* ctl = (unsigned*)(ws + WS_CTL);
    if (F.tid < 4) ((LAS unsigned*)(F.lds + MISC_OFF))[F.tid] = 0u;
    __syncthreads();
    const int lo = args.ph_lo, hi = args.ph_hi;
    XcdBarrier bar; bar.bar = ctl + CW_BAR; bar.x = 0; bar.st = nullptr;
    if (hi - lo > 1) bar = xcd_barrier_post(ctl + CW_BAR, (volatile LAS unsigned*)(F.lds + MISC_OFF));
#ifndef PH_ONLY
#define PH_ONLY -1
#endif
#define PEN(c) (PH_ONLY < 0 || PH_ONLY == (c))
#ifndef DUP_MASK
#define DUP_MASK 0
#endif
#define REPS(c) (1 + ((DUP_MASK >> (c)) & 1))
#define DUPSEAM(c, k) do { if (rep_ + 1 < REPS(c)) xcd_barrier(bar); else SEAM(k); } while (0)
#define IN(k) (lo <= (k) && (k) < hi)
#define BOTH(k) (IN(k) && IN((k) + 1))
#define SEAM(k) do { if (BOTH(k)) xcd_barrier(bar); } while (0)
    if (PEN(0) && IN(0)) for (int rep_ = 0; rep_ < REPS(0); ++rep_) { ph_prologue(args, F); DUPSEAM(0, 0); }
    if (PEN(1) && IN(1)) { const float* mod0 = (const float*)(ws + WS_MOD); ph_norm(F, args.in[I_X], args.in[I_GMIX], mod0, 0, DM, (bf16_t*)(ws + WS_H)); SEAM(1); }
    unsigned char* const ws0 = ws;
    const Args args0 = args;
    for (int l = 0; l < NLAYER; ++l) {
        const int pb = 2 + 8 * l;
        size_t wz = 0; asm volatile("" : "+s"(wz));
        unsigned char* const ws = ws0 + wz;
        Args args = args0; args.ws = ws;
        const float* modl = (const float*)(ws + WS_MOD) + (size_t)l * NBATCH * MODW;
        if (PEN(2) && IN(pb + 0)) for (int rep_ = 0; rep_ < REPS(2); ++rep_) {
            unsigned char* const ws = args.ws + opq0();
            pg8::SchedPlain S; S.init(ws + WS_H, (const unsigned char*)(ws + WS_WIN) + (size_t)l * QKVW * DM, NTOK, QKVW, DM, 1, F.G, (int)blockIdx.x);
            pg8::EpiBf16 E{(bf16_t*)(ws + WS_QKV), QKVW, 0.18033688011112042f};
            pg8::gemm_phase<DM, true>(F.lds, S, E);
            DUPSEAM(2, pb + 0);
        }
        if (PEN(3) && IN(pb + 1)) for (int rep_ = 0; rep_ < REPS(3); ++rep_) { ph_attention1(args, F, l, rep_); DUPSEAM(3, pb + 1); }
        if (PEN(10) && IN(pb + 2)) for (int rep_ = 0; rep_ < REPS(10); ++rep_) { ph_attention2(args, F, l, rep_); DUPSEAM(10, pb + 2); }
        if (PEN(5) && IN(pb + 3)) for (int rep_ = 0; rep_ < REPS(5); ++rep_) {
            unsigned char* const ws = args.ws + opq0();
            pg8::SchedPlain S; S.init(ws + WS_OCAT, (const unsigned char*)(ws + WS_WOUT) + (size_t)l * DM * DM, NTOK, DM, DM, 1, F.G, (int)blockIdx.x);
            pg8::EpiResid E{l == 0 ? args.in[I_X] : nullptr, l == 0 ? nullptr : (const bf16_t*)(ws + WS_XB), (bf16_t*)(ws + WS_XA), modl + 2 * DM};
            pg8::gemm_phase<DM, true>(F.lds, S, E);
            DUPSEAM(5, pb + 3);
        }
        if (PEN(6) && IN(pb + 4)) { ph_router(args, F, l); SEAM(pb + 4); }
        if (PEN(7) && IN(pb + 5)) for (int rep_ = 0; rep_ < REPS(7); ++rep_) {
            moe_tables(args, F, l);
            unsigned char* const ws = args.ws + opq0();
            pg8::SchedMoE<true> S; S.abase = (const char*)(ws + WS_H); S.wbase = (const char*)(ws + WS_WGU) + (size_t)l * NEX * 1024 * DM; S.wstride = (size_t)1024 * DM;
            S.toklist = (const int*)(ws + WS_TOK); S.bs = (const LAS int*)(F.lds + TAB_BS_OFF); S.cn = (const LAS int*)(F.lds + TAB_CNT_OFF); S.npn = 4; S.G = F.G; S.c = F.vcu; S.rb = DM; S.ut = (const LAS int*)(F.lds + TAB_UNIT_OFF); S.build_units((LAS int*)(F.lds + TAB_UNIT_OFF), F.tid);
            pg8::EpiSwiglu E{(unsigned char*)(ws + WS_UBUF)};
            pg8::gemm_phase<DM, true>(F.lds, S, E);
            DUPSEAM(7, pb + 5);
        }
        if (PEN(8) && IN(pb + 6)) for (int rep_ = 0; rep_ < REPS(8); ++rep_) {
            moe_tables(args, F, l);
            unsigned char* const ws = args.ws + opq0();
            pg8::SchedMoE<false> S; S.abase = (const char*)(ws + WS_UBUF); S.wbase = (const char*)(ws + WS_WD) + (size_t)l * NEX * DM * EDIM; S.wstride = (size_t)DM * EDIM;
            S.toklist = nullptr; S.bs = (const LAS int*)(F.lds + TAB_BS_OFF); S.cn = (const LAS int*)(F.lds + TAB_CNT_OFF); S.npn = 8; S.G = F.G; S.c = F.vcu; S.rb = EDIM; S.ut = (const LAS int*)(F.lds + TAB_UNIT_OFF); S.build_units((LAS int*)(F.lds + TAB_UNIT_OFF), F.tid);
            pg8::EpiF8 E{(unsigned char*)(ws + WS_YBUF), DM};
            pg8::gemm_phase<EDIM, true>(F.lds, S, E);
            DUPSEAM(8, pb + 6);
        }
        if (PEN(9) && IN(pb + 7)) for (int rep_ = 0; rep_ < REPS(9); ++rep_) { moe_tables(args, F, l); ph_combine(args, F, l); DUPSEAM(9, pb + 7); }
    }
#undef IN
#undef BOTH
#undef SEAM
}

extern "C" void kernel_launch(void* const* d_in, const int* in_sizes, int n_in, void* d_out, int out_size, void* d_ws, size_t ws_size, hipStream_t stream) {
    static int grid = 0;
    if (grid == 0) {
        if (n_in != 23 || out_size != NTOK * DM || ws_size < WS_END) { fprintf(stderr, "kernel_launch: unexpected shapes (n_in %d out %d ws %zu, need %zu)\n", n_in, out_size, ws_size, (size_t)WS_END); grid = -1; return; }
        int dev = 0, cus = 0;
        if (hipGetDevice(&dev) != hipSuccess || hipDeviceGetAttribute(&cus, hipDeviceAttributeMultiprocessorCount, dev) != hipSuccess) { grid = -1; return; }
        if (hipFuncSetAttribute((const void*)fwd_kernel, hipFuncAttributeMaxDynamicSharedMemorySize, LDS_BYTES) != hipSuccess) { fprintf(stderr, "kernel_launch: hipFuncSetAttribute failed\n"); grid = -1; return; }
        int per_cu = 0;
        if (hipOccupancyMaxActiveBlocksPerMultiprocessor(&per_cu, (const void*)fwd_kernel, 512, LDS_BYTES) != hipSuccess || per_cu < 1) { fprintf(stderr, "kernel_launch: occupancy query says %d\n", per_cu); }
        (void)hipGetLastError();
        grid = cus;
    }
    if (grid < 0) return;
    if (hipMemsetAsync((char*)d_ws + WS_CTL, 0, CTL_ZERO_BYTES, stream) != hipSuccess) return;
    Args a{};
    for (int i = 0; i < 23; ++i) a.in[i] = (const float*)d_in[i];
    a.out = (float*)d_out; a.ws = (unsigned char*)d_ws;
#if MK_PER_PHASE
    for (int p = 0; p < N_PHASES; ++p) { a.ph_lo = p; a.ph_hi = p + 1; hipLaunchKernelGGL(fwd_kernel, dim3(grid), dim3(512), LDS_BYTES, stream, a); }
#else
    a.ph_lo = 0; a.ph_hi = N_PHASES;
    hipLaunchKernelGGL(fwd_kernel, dim3(grid), dim3(512), LDS_BYTES, stream, a);
#endif
}
```

```cpp
#include <hip/hip_runtime.h>
#include <cstdio>
#include <cstdint>

#ifndef MK_PER_PHASE
#define MK_PER_PHASE 0
#endif
#ifndef DUP_MASK
#define DUP_MASK 0
#endif
#ifndef MK_DEBUG
#define MK_DEBUG 0
#endif

#define LAS __attribute__((address_space(3)))
#define GAS __attribute__((address_space(1)))
typedef unsigned short bf16_t;
typedef short bf16x8 __attribute__((ext_vector_type(8)));
typedef short s16x4 __attribute__((ext_vector_type(4)));
typedef float f32x2 __attribute__((ext_vector_type(2)));
typedef float f32x4 __attribute__((ext_vector_type(4)));
typedef float f32x16 __attribute__((ext_vector_type(16)));
typedef unsigned u32x2 __attribute__((ext_vector_type(2)));
typedef unsigned u32x4 __attribute__((ext_vector_type(4)));

constexpr int DM = 2048, NBATCH = 4, SEQ = 4096, NTOK = NBATCH * SEQ, NLAYER = 2, HD = 128, QKVW = 3 * DM;
constexpr int NE = 64, TOPK = 8, EDIM = 512, MODW = 6 * DM;
constexpr int NEX = NE + 1;
constexpr int MAXROWS = NTOK * TOPK + NE * 256 + NTOK;
constexpr float NORM_EPS = 1e-6f, SUBLN_EPS = 1e-5f;

constexpr size_t MiB = (size_t)1 << 20;
constexpr size_t WS_CTL = 0, CTL_ZERO_BYTES = 1 * MiB;
constexpr size_t WS_MOD = 1 * MiB;
constexpr size_t WS_TOK = 2 * MiB;
constexpr size_t WS_SLOT = 6 * MiB;
constexpr size_t WS_ALSE = 7 * MiB;
constexpr size_t WS_WRH = WS_MOD + 448 * 1024;
constexpr size_t WS_WRL = WS_ALSE + 1536 * 1024;
constexpr size_t WS_WIN = 9 * MiB;
constexpr size_t WS_WOUT = 57 * MiB;
constexpr size_t WS_WGU = 73 * MiB;
constexpr size_t WS_WD = 593 * MiB;
constexpr size_t WS_XA = 853 * MiB;
constexpr size_t WS_XB = 981 * MiB;
constexpr size_t WS_H = 1109 * MiB;
constexpr size_t WS_OV = 1173 * MiB;
constexpr size_t WS_QKV = WS_OV, WS_OCAT = WS_OV + 192 * MiB, WS_APART = WS_OV + 256 * MiB;
constexpr size_t WS_UBUF = WS_OV, WS_YBUF = WS_OV + 160 * MiB;
constexpr size_t WS_END = WS_OV + 800 * MiB;
static_assert(WS_APART + (size_t)3 * NTOK * 1024 * 2 <= WS_END && WS_YBUF + (size_t)MAXROWS * DM * 2 <= WS_END && (size_t)MAXROWS * EDIM * 2 <= 160 * MiB, "ws map");
constexpr int CW_BAR = 4096;
constexpr int CW_CNT = 8192;
constexpr int CW_FAIL = 8448;
constexpr int CW_KMAX = 8704;
constexpr int CW_QB = 8832;
constexpr int CW_QM = 9856;
constexpr int CW_QC2 = 9088, CW_QA = 9344, CW_QV = 9600;

constexpr int RING_BYTES = 131072;
constexpr int MISC_OFF = RING_BYTES;
constexpr int TAB_BS_OFF = MISC_OFF + 64;
constexpr int TAB_CNT_OFF = MISC_OFF + 64 + 320;
constexpr int TAB_UNIT_OFF = MISC_OFF + 1024;
constexpr int LDS_BYTES = 147456;

__device__ __forceinline__ unsigned cvt_pk_bf16(float lo, float hi) { unsigned r; asm volatile("v_cvt_pk_bf16_f32 %0, %1, %2" : "=v"(r) : "v"(lo), "v"(hi)); return r; }
__device__ __forceinline__ float bf2f(unsigned short b) { return __uint_as_float(((unsigned)b) << 16); }
__device__ __forceinline__ float bflo(unsigned w) { return __uint_as_float(w << 16); }
__device__ __forceinline__ float bfhi(unsigned w) { return __uint_as_float(w & 0xffff0000u); }
__device__ __forceinline__ int lane_now() { int l = (int)__builtin_amdgcn_mbcnt_hi(~0u, __builtin_amdgcn_mbcnt_lo(~0u, 0u)); asm volatile("" : "+v"(l)); return l; }
__device__ __forceinline__ int shx(int v, int off) { return __builtin_amdgcn_ds_bpermute((lane_now() ^ off) << 2, v); }
__device__ __forceinline__ float shx(float v, int off) { return __int_as_float(__builtin_amdgcn_ds_bpermute((lane_now() ^ off) << 2, __float_as_int(v))); }
__device__ __forceinline__ int shf(int v, int src) { return __builtin_amdgcn_ds_bpermute(src << 2, v); }
__device__ __forceinline__ float shf(float v, int src) { return __int_as_float(__builtin_amdgcn_ds_bpermute(src << 2, __float_as_int(v))); }
__device__ __forceinline__ float rdl(float v, int src) { return __int_as_float(__builtin_amdgcn_readlane(__float_as_int(v), src)); }
template <int CTRL> __device__ __forceinline__ float dppf(float v) { return __int_as_float(__builtin_amdgcn_update_dpp(0, __float_as_int(v), CTRL, 0xf, 0xf, true)); }
template <int CTRL> __device__ __forceinline__ int dppi(int v) { return __builtin_amdgcn_update_dpp(0, v, CTRL, 0xf, 0xf, true); }
__device__ __forceinline__ float gmax8(float v) { v = fmaxf(v, dppf<0xB1>(v)); v = fmaxf(v, dppf<0x4E>(v)); return fmaxf(v, dppf<0x141>(v)); }
__device__ __forceinline__ int gmin8(int v) { v = min(v, dppi<0xB1>(v)); v = min(v, dppi<0x4E>(v)); return min(v, dppi<0x141>(v)); }
__device__ __forceinline__ float row_sum16(float v) { v += dppf<0xB1>(v); v += dppf<0x4E>(v); v += dppf<0x141>(v); return v + dppf<0x140>(v); }
__device__ __forceinline__ float wave_sum(float v) { v = row_sum16(v); return (rdl(v, 0) + rdl(v, 16)) + (rdl(v, 32) + rdl(v, 48)); }
__device__ __forceinline__ int launder_i(int v) { asm volatile("" : "+v"(v)); return v; }
__device__ __forceinline__ size_t opq0() { size_t z = 0; asm volatile("" : "+s"(z)); return z; }
__device__ __forceinline__ float sat8(float x) { return __builtin_amdgcn_fmed3f(x, -448.0f, 448.0f); }
__device__ __forceinline__ unsigned pk4_fp8w(float a, float b, float c, float d) { int w = __builtin_amdgcn_cvt_pk_fp8_f32(a, b, 0, false); w = __builtin_amdgcn_cvt_pk_fp8_f32(c, d, w, true); return (unsigned)w; }
__device__ __forceinline__ unsigned pk4_fp8(float a, float b, float c, float d) { int w = __builtin_amdgcn_cvt_pk_fp8_f32(sat8(a), sat8(b), 0, false); w = __builtin_amdgcn_cvt_pk_fp8_f32(sat8(c), sat8(d), w, true); return (unsigned)w; }
typedef int v4i_t __attribute__((ext_vector_type(4)));
typedef int v8i_t __attribute__((ext_vector_type(8)));
#define LDS_WAIT() asm volatile("s_waitcnt lgkmcnt(0)" ::: "memory")
#define VM_WAIT() asm volatile("s_waitcnt vmcnt(0)" ::: "memory")

#define XB_TMO      128
#define XB_XCNT(j)  (256  + 64 * (j))
#define XB_XSUB(j)  (1280 + 64 * (j))
#define XB_XGEN(j)  (2304 + 64 * (j))
#define XB_TOP      3328
#define XB_TOPGEN   3392
#define XCD_BAR_WORDS 3456
#define XB_SPIN_CAP (1u << 20)

__device__ __forceinline__ unsigned xb_ld(unsigned* p)              { return __hip_atomic_load(p, __ATOMIC_RELAXED, __HIP_MEMORY_SCOPE_AGENT); }
__device__ __forceinline__ unsigned xb_add(unsigned* p, unsigned v) { return __hip_atomic_fetch_add(p, v, __ATOMIC_RELAXED, __HIP_MEMORY_SCOPE_AGENT); }
__device__ __forceinline__ unsigned xb_xcc_id() { return (unsigned)__builtin_amdgcn_s_getreg((3 << 11) | 20) & 0xFu; }
#define XB_SPIN(cond, bar) do { unsigned _sp = 0; while (cond) { __builtin_amdgcn_s_sleep(1); \
    if ((++_sp & 255u) == 0u) { if (xb_ld(&(bar)[XB_TMO])) break; if (_sp > XB_SPIN_CAP) { atomicAdd(&(bar)[XB_TMO], 1u); break; } } } } while (0)

struct XcdBarrier { unsigned* bar; unsigned x; volatile LAS unsigned* st; };

__device__ __forceinline__ XcdBarrier xcd_barrier_post(unsigned* bar, volatile LAS unsigned* st) {
    XcdBarrier b; b.bar = bar; b.x = xb_xcc_id(); b.st = st;
    if (threadIdx.x == 0) (void)xb_add(&bar[XB_XCNT(b.x)], 1u);
    return b;
}
__device__ __forceinline__ void xcd_barrier_complete(unsigned* bar, unsigned x, unsigned& nloc, unsigned& nx) {
    const unsigned G = gridDim.x * gridDim.y * gridDim.z;
    unsigned sum, cnt, mine, sp = 0u;
    for (;;) {
        sum = 0u; cnt = 0u; mine = 0u;
#pragma unroll
        for (unsigned j = 0; j < 16; ++j) { const unsigned c = xb_ld(&bar[XB_XCNT(j)]); sum += c; cnt += (c > 0u) ? 1u : 0u; mine = (j == x) ? c : mine; }
        if (sum == G) break;
        __builtin_amdgcn_s_sleep(1);
        if ((++sp & 255u) == 0u) { if (xb_ld(&bar[XB_TMO])) break; if (sp > XB_SPIN_CAP) { atomicAdd(&bar[XB_TMO], 1u); break; } }
    }
    nloc = mine > 0u ? mine : 1u; nx = cnt > 0u ? cnt : 1u;
}
__device__ __forceinline__ void xcd_barrier(const XcdBarrier& b) {
    asm volatile("s_waitcnt vmcnt(0)" ::: "memory");
    __syncthreads();
    if (threadIdx.x == 0) {
        unsigned* bar = b.bar + opq0();
        __builtin_amdgcn_s_waitcnt(0);
        unsigned nloc = b.st[0], nx = b.st[1];
        if (nloc == 0u) { xcd_barrier_complete(bar, b.x, nloc, nx); b.st[0] = nloc; b.st[1] = nx; }
        const unsigned old = xb_add(&bar[XB_XSUB(b.x)], 1u);
        const unsigned gen = old / nloc;
        if (old + 1u == (gen + 1u) * nloc) {
            __builtin_amdgcn_fence(__ATOMIC_RELEASE, "agent");
            asm volatile("s_waitcnt vmcnt(0)" ::: "memory");
            const unsigned og = xb_add(&bar[XB_TOP], 1u);
            const unsigned tg = og / nx;
            if (og + 1u == (tg + 1u) * nx) xb_add(&bar[XB_TOPGEN], 1u);
            else XB_SPIN(xb_ld(&bar[XB_TOPGEN]) == tg, bar);
            __builtin_amdgcn_fence(__ATOMIC_ACQUIRE, "agent");
            xb_add(&bar[XB_XGEN(b.x)], 1u);
            asm volatile("s_waitcnt vmcnt(0)" ::: "memory");
        } else {
            XB_SPIN(xb_ld(&bar[XB_XGEN(b.x)]) == gen, bar);
            __builtin_amdgcn_fence(__ATOMIC_ACQUIRE, "agent");
            asm volatile("s_waitcnt vmcnt(0)" ::: "memory");
        }
    }
    __syncthreads();
}

namespace pg8 {
constexpr int BM = 256, BK = 64, HALF = 128, HTB = HALF * BK * 2, STAGE_BYTES = 8 * HTB, NXCD = 8, WGM = 8;
__host__ __device__ __forceinline__ int lds_byte(int r, int c) { const int st = (r >> 4) * 2 + (c >> 5), rr = r & 15, cc = c & 31, ob = rr * 64 + cc * 2; return st * 1024 + (ob ^ (((ob >> 9) & 1) << 5)); }
__host__ __device__ __forceinline__ void stage_rc(int b, int& R, int& C) { const int st = b / 1024, sb = b % 1024, swz = sb ^ (((sb >> 9) & 1) << 5); R = (st >> 1) * 16 + swz / 64; C = (st & 1) * 32 + (swz % 64) / 2; }
__host__ __device__ __forceinline__ int perm32(int rho) { const int n = rho >> 4, i = rho & 15; return 8 * (i >> 2) + 4 * n + (i & 3); }

struct Unit { int pm, pn, e, orow0, cnt; };

struct SchedPlain {
    static constexpr bool GATHERS = false;
    const char* abase; const char* bbase; int nM, nN, nwg, G, c, rb;
    __device__ void init(const void* A, const void* Bt, int M, int N, int K_, int esz, int G_, int c_) { abase = (const char*)A; bbase = (const char*)Bt; nM = M / BM; nN = N / BM; nwg = nM * nN; G = G_; c = c_; rb = K_ * esz; }
    __device__ __forceinline__ bool next(int i, Unit& u) const {
        const long L = (long)i * G + c; if (L >= nwg) return false;
        int wgid = (int)L; { const int q = nwg / NXCD, r = nwg % NXCD, xcd = wgid % NXCD, off = wgid / NXCD; wgid = (xcd < r ? xcd * (q + 1) : r * (q + 1) + (xcd - r) * q) + off; }
        const int nig = WGM * nN, gid = wgid / nig, fm = gid * WGM, gsz = (nM - fm) < WGM ? (nM - fm) : WGM;
        u.pm = fm + ((wgid % nig) % gsz); u.pn = (wgid % nig) / gsz; u.e = 0; u.orow0 = u.pm * BM; u.cnt = BM; return true;
    }
    __device__ __forceinline__ unsigned arow_off(const Unit& u, int r) const { return (unsigned)(u.pm * BM + r) * (unsigned)rb; }
    __device__ __forceinline__ const char* btile(const Unit& u) const { return bbase + (size_t)u.pn * BM * rb; }
};
template <bool GATHER> struct SchedMoE {
    static constexpr bool GATHERS = GATHER;
    const char* abase; const char* wbase; size_t wstride; const int* toklist; const LAS int* bs; const LAS int* cn; int npn, G, c, rb;
    const LAS int* ut;
    __device__ __forceinline__ bool search(int i, Unit& u) const {
        const int L = i * G + c, total = bs[NEX] * npn; if (L >= total) return false;
        int lo = 0, hi = NE;
        while (lo < hi) { const int mid = (lo + hi + 1) >> 1; if (bs[mid] * npn <= L) lo = mid; else hi = mid - 1; }
        const int e = lo, rem = L - bs[e] * npn, nb = bs[e + 1] - bs[e];
        u.e = e; u.pn = rem / nb; u.pm = rem % nb; u.orow0 = (bs[e] + u.pm) * BM; u.cnt = cn[e] - u.pm * BM; return true;
    }
    __device__ __forceinline__ void build_units(LAS int* tab, int tid) const {
        if (tid < 32) { Unit u; const bool ok = search(tid, u); LAS int* t = tab + tid * 8; t[0] = ok ? u.pm : -1; t[1] = u.pn; t[2] = u.e; t[3] = u.orow0; t[4] = u.cnt; }
        __syncthreads();
    }
    __device__ __forceinline__ bool next(int i, Unit& u) const {
        if (i >= 32) return false;
        const LAS int* t = ut + i * 8; const int pm = t[0]; if (pm < 0) return false;
        u.pm = pm; u.pn = t[1]; u.e = t[2]; u.orow0 = t[3]; u.cnt = t[4]; return true;
    }
    __device__ __forceinline__ unsigned arow_off(const Unit& u, int r) const {
        if (GATHER) { int tok; if (u.e == NE) tok = u.pm * BM + r; else tok = (r < u.cnt) ? toklist[u.e * NTOK + u.pm * BM + r] : 0; return (unsigned)tok * (unsigned)rb; }
        else return (unsigned)(u.orow0 + r) * (unsigned)rb;
    }
    __device__ __forceinline__ const char* btile(const Unit& u) const { return wbase + (size_t)u.e * wstride + (size_t)u.pn * BM * rb; }
};

struct EpiBf16 {
    static constexpr bool PERM = true; static constexpr int BH = 32, NVM = 16;
    static __device__ __forceinline__ int brow(int R) { return 64 * (R >> 5) + 8 * ((R & 15) >> 2) + 4 * ((R >> 4) & 1) + (R & 3); }
    bf16_t* O; int ldc; float qscale;
    __device__ __forceinline__ void operator()(const f32x4 (&acc)[2][2][4][2], const Unit& u, int wr, int wc, int fr, int fq) const {
        fr = launder_i(fr); fq = launder_i(fq);
        const float sc = (u.pn == 4 || u.pn == 5) ? qscale : 1.0f;
        const int row0 = u.orow0 + wr * 64 + fr, col0 = u.pn * BM + wc * 64 + 8 * fq;
#pragma unroll
        for (int ai = 0; ai < 2; ++ai)
#pragma unroll
            for (int m = 0; m < 4; ++m) { bf16_t* rowp = O + (size_t)(row0 + ai * HALF + m * 16) * ldc + col0;
#pragma unroll
                for (int bj = 0; bj < 2; ++bj) { const f32x4 v0 = acc[ai][bj][m][0], v1 = acc[ai][bj][m][1];
                    u32x4 w; w.x = cvt_pk_bf16(v0[0] * sc, v0[1] * sc); w.y = cvt_pk_bf16(v0[2] * sc, v0[3] * sc); w.z = cvt_pk_bf16(v1[0] * sc, v1[1] * sc); w.w = cvt_pk_bf16(v1[2] * sc, v1[3] * sc);
                    *(u32x4*)(rowp + bj * 32) = w; } }
    }
};
struct EpiF8 {
    static constexpr bool PERM = true; static constexpr int BH = 8, NVM = 8;
    static __device__ __forceinline__ int brow(int R) { return 64 * (R >> 5) + 16 * ((R & 15) >> 2) + 4 * ((R >> 4) & 1) + (R & 3); }
    unsigned char* O; int ldc;
    __device__ __forceinline__ void operator()(const f32x4 (&acc)[2][2][4][2], const Unit& u, int wr, int wc, int fr, int fq) const {
        fr = launder_i(fr); fq = launder_i(fq);
        const int row0 = u.orow0 + wr * 64 + fr, col0 = u.pn * BM + wc * 64 + 16 * fq;
#pragma unroll
        for (int ai = 0; ai < 2; ++ai)
#pragma unroll
            for (int m = 0; m < 4; ++m) { unsigned char* rowp = O + (size_t)(row0 + ai * HALF + m * 16) * ldc + col0;
                const f32x4 a0 = acc[ai][0][m][0], a1 = acc[ai][0][m][1], b0 = acc[ai][1][m][0], b1 = acc[ai][1][m][1];
                u32x4 w; w.x = pk4_fp8(a0[0], a0[1], a0[2], a0[3]); w.y = pk4_fp8(a1[0], a1[1], a1[2], a1[3]); w.z = pk4_fp8(b0[0], b0[1], b0[2], b0[3]); w.w = pk4_fp8(b1[0], b1[1], b1[2], b1[3]);
                *(u32x4*)rowp = w; }
    }
};
struct EpiResid {
    static constexpr bool PERM = true; static constexpr int BH = 8, NVM = 0;
    static __device__ __forceinline__ int brow(int R) { return 64 * (R >> 5) + 16 * ((R & 15) >> 2) + 4 * ((R >> 4) & 1) + (R & 3); }
    const float* xin32; const bf16_t* xin16; bf16_t* out; const float* gate;
    __device__ __forceinline__ void operator()(const f32x4 (&acc)[2][2][4][2], const Unit& u, int wr, int wc, int fr, int fq) const {
        fr = launder_i(fr); fq = launder_i(fq);
        const int row0 = u.orow0 + wr * 64 + fr, col0 = u.pn * BM + wc * 64 + 16 * fq, b = u.orow0 / SEQ;
        f32x4 gv[4];
#pragma unroll
        for (int q = 0; q < 4; ++q) gv[q] = *(const f32x4*)(gate + (size_t)b * MODW + col0 + 4 * q);
#pragma unroll
        for (int ai = 0; ai < 2; ++ai)
#pragma unroll
            for (int m = 0; m < 4; ++m) { const size_t off = (size_t)(row0 + ai * HALF + m * 16) * DM + col0;
                f32x4 xs[4];
                if (xin32) {
#pragma unroll
                    for (int q = 0; q < 4; ++q) xs[q] = *(const f32x4*)(xin32 + off + 4 * q);
                } else { const u32x4 w0 = *(const u32x4*)(xin16 + off), w1 = *(const u32x4*)(xin16 + off + 8);
                    xs[0] = (f32x4){bflo(w0.x), bfhi(w0.x), bflo(w0.y), bfhi(w0.y)}; xs[1] = (f32x4){bflo(w0.z), bfhi(w0.z), bflo(w0.w), bfhi(w0.w)};
                    xs[2] = (f32x4){bflo(w1.x), bfhi(w1.x), bflo(w1.y), bfhi(w1.y)}; xs[3] = (f32x4){bflo(w1.z), bfhi(w1.z), bflo(w1.w), bfhi(w1.w)}; }
                u32x4 o[2];
#pragma unroll
                for (int bj = 0; bj < 2; ++bj) { const f32x4 r0 = xs[2 * bj] + gv[2 * bj] * acc[ai][bj][m][0], r1 = xs[2 * bj + 1] + gv[2 * bj + 1] * acc[ai][bj][m][1];
                    o[bj].x = cvt_pk_bf16(r0[0], r0[1]); o[bj].y = cvt_pk_bf16(r0[2], r0[3]); o[bj].z = cvt_pk_bf16(r1[0], r1[1]); o[bj].w = cvt_pk_bf16(r1[2], r1[3]); }
                *(u32x4*)(out + off) = o[0]; *(u32x4*)(out + off + 8) = o[1];
                if (m & 1) asm volatile("" ::: "memory"); }
    }
};
struct EpiSwiglu {
    static constexpr bool PERM = true; static constexpr int BH = 4;
    static __device__ __forceinline__ int brow(int R) { return 64 * (R >> 5) + 32 * ((R >> 4) & 1) + 8 * ((R & 15) >> 2) + (R & 3); }
    unsigned char* U;
    __device__ __forceinline__ void operator()(const f32x4 (&acc)[2][2][4][2], const Unit& u, int wr, int wc, int fr, int fq) const {
        fr = launder_i(fr); fq = launder_i(fq);
        const int row0 = u.orow0 + wr * 64 + fr, j0 = u.pn * 128 + wc * 32 + 8 * fq;
#pragma unroll
        for (int ai = 0; ai < 2; ++ai)
#pragma unroll
            for (int m = 0; m < 4; ++m) { unsigned char* rowp = U + (size_t)(row0 + ai * HALF + m * 16) * EDIM + j0; u32x2 w;
#pragma unroll
                for (int bj = 0; bj < 2; ++bj) { const f32x4 g = acc[ai][bj][m][0], up = acc[ai][bj][m][1]; f32x4 v;
#pragma unroll
                    for (int t = 0; t < 4; ++t) v[t] = g[t] * __builtin_amdgcn_rcpf(1.0f + __expf(-g[t])) * up[t];
                    w[bj] = pk4_fp8(v[0], v[1], v[2], v[3]); }
                *(u32x2*)rowp = w; }
    }
};

template <int RB, bool F8, class Epi, class Sched>
__device__ __forceinline__ void gemm_phase(LAS unsigned char* lds, const Sched& S, const Epi& E) {
    const int tid = launder_i((int)threadIdx.x), wid = __builtin_amdgcn_readfirstlane(tid >> 6), lane = tid & 63, wr = wid >> 2, wc = wid & 3, fr = lane & 15, fq = lane >> 4;
    constexpr int nt = RB / 128;
    static_assert(RB % 256 == 0 && RB >= 512, "row bytes: multiple of 256, >= 512");
    unsigned voffB[2];
#pragma unroll
    for (int i = 0; i < 2; ++i) { int R, C; stage_rc(tid * 16 + i * 8192, R, C); const int Rb = Epi::brow(R); voffB[i] = (unsigned)(Rb * RB + C * 2); }
#define PG8_AOFF(u, vo0, vo1) do { _Pragma("unroll") for (int i_ = 0; i_ < 2; ++i_) { int R_, C_; stage_rc(launder_i(tid) * 16 + i_ * 8192, R_, C_); \
        (vo0)[i_] = S.arow_off((u), R_) + (unsigned)(C_ * 2); (vo1)[i_] = S.arow_off((u), HALF + R_) + (unsigned)(C_ * 2); } } while (0)
    constexpr size_t kstep = (size_t)(BK * 2);
    constexpr size_t hstepB = (size_t)Epi::BH * RB;
    const unsigned ldsw = (unsigned)wid * 1024u;
    const int aoff = lds_byte(wr * 64 + fr, fq * 8), boff = lds_byte(wc * 32 + fr, fq * 8);
#define PG8_SA(b, h) (((b) * 2 + (h)) * HTB)
#define PG8_SB(b, h) ((4 + (b) * 2 + (h)) * HTB)
#define PG8_STAGE(bufoff, gbase, voff) do { _Pragma("unroll") for (int _i = 0; _i < 2; ++_i) \
        __builtin_amdgcn_global_load_lds((const unsigned*)((const char*)(gbase) + (voff)[_i]), (LAS unsigned*)(lds + (bufoff) + ldsw + _i * 8192), 16, 0, 0); } while (0)
#define PG8_LD32(dstv, off) do { const v4i_t lo_ = *(const LAS v4i_t*)(lds + (off)), hi_ = *(const LAS v4i_t*)(lds + (off) + 1024); (dstv) = __builtin_shufflevector(lo_, hi_, 0, 1, 2, 3, 4, 5, 6, 7); } while (0)
#define PG8_LDA(dst, b, h) do { _Pragma("unroll") for (int m = 0; m < 4; ++m) PG8_LD32(dst[m].v, PG8_SA(b, h) + aoff + m * 2048); } while (0)
#define PG8_LDB(dst, b, h) do { _Pragma("unroll") for (int n = 0; n < 2; ++n) PG8_LD32(dst[n].v, PG8_SB(b, h) + boff + n * 2048); } while (0)
#define PG8_LO(x) __builtin_bit_cast(bf16x8, __builtin_shufflevector((x), (x), 0, 1, 2, 3))
#define PG8_HI(x) __builtin_bit_cast(bf16x8, __builtin_shufflevector((x), (x), 4, 5, 6, 7))
#define PG8_MMA(ai, bj, At, Bt) do { __builtin_amdgcn_s_setprio(1); \
        if constexpr (!F8) { _Pragma("unroll") for (int m = 0; m < 4; ++m) _Pragma("unroll") for (int n = 0; n < 2; ++n) { \
            acc[ai][bj][m][n] = __builtin_amdgcn_mfma_f32_16x16x32_bf16(PG8_LO(Bt[n].v), PG8_LO(At[m].v), acc[ai][bj][m][n], 0, 0, 0); \
            acc[ai][bj][m][n] = __builtin_amdgcn_mfma_f32_16x16x32_bf16(PG8_HI(Bt[n].v), PG8_HI(At[m].v), acc[ai][bj][m][n], 0, 0, 0); } } \
        else { _Pragma("unroll") for (int m = 0; m < 4; ++m) _Pragma("unroll") for (int n = 0; n < 2; ++n) \
            asm volatile("v_mfma_scale_f32_16x16x128_f8f6f4 %0, %1, %2, %0, %3, %4 op_sel_hi:[0,0,0]" : "+v"(acc[ai][bj][m][n]) : "v"(Bt[n].v), "v"(At[m].v), "v"(scl_w), "v"(scl_a)); } \
        __builtin_amdgcn_s_setprio(0); } while (0)
#define PG8_MMAZ(ai, bj, At, Bt) do { __builtin_amdgcn_s_setprio(1); \
        _Pragma("unroll") for (int m = 0; m < 4; ++m) _Pragma("unroll") for (int n = 0; n < 2; ++n) \
            asm volatile("v_mfma_scale_f32_16x16x128_f8f6f4 %0, %1, %2, 0, %3, %4 op_sel_hi:[0,0,0]" : "=&v"(acc[ai][bj][m][n]) : "v"(Bt[n].v), "v"(At[m].v), "v"(scl_w), "v"(scl_a)); \
        __builtin_amdgcn_s_setprio(0); } while (0)
#define PG8_WAIT_V(n) asm volatile("s_waitcnt vmcnt(" #n ")" ::: "memory")
#define PG8_WAIT_L(n) asm volatile("s_waitcnt lgkmcnt(" #n ")" ::: "memory")
#define PG8_BAR __builtin_amdgcn_s_barrier()
#define PG8_SCHED __builtin_amdgcn_sched_barrier(0)
    Unit cur, nxt; int ui = 0;
    if (!S.next(0, cur)) return;
    int scl_w = 0x7a7a7a7a, scl_a = 0x7f7f7f7f;
    asm volatile("" : "+v"(scl_w), "+v"(scl_a));
    f32x4 acc[2][2][4][2];
    if constexpr (!F8) {
#pragma unroll
    for (int a = 0; a < 2; ++a)
#pragma unroll
        for (int b = 0; b < 2; ++b)
#pragma unroll
            for (int m = 0; m < 4; ++m)
#pragma unroll
                for (int n = 0; n < 2; ++n) acc[a][b][m][n] = (f32x4){0.f, 0.f, 0.f, 0.f};
    }
    struct Frag { v8i_t v; };
    Frag At[4], B0[2], B1[2];
    unsigned cvo0[2], cvo1[2];
    PG8_AOFF(cur, cvo0, cvo1);
    const char* const Ab = S.abase; const char* cB = S.btile(cur);
    PG8_STAGE(PG8_SB(0, 0), cB, voffB); PG8_STAGE(PG8_SB(0, 1), cB + hstepB, voffB); PG8_STAGE(PG8_SA(0, 0), Ab, cvo0); PG8_STAGE(PG8_SA(0, 1), Ab, cvo1);
    if (wr == 1) PG8_BAR;
    PG8_WAIT_V(2); PG8_BAR;
    PG8_STAGE(PG8_SB(1, 0), cB + kstep, voffB); PG8_STAGE(PG8_SA(1, 0), Ab + kstep, cvo0); PG8_STAGE(PG8_SB(1, 1), cB + hstepB + kstep, voffB);
    PG8_WAIT_V(6); PG8_BAR;
    for (;;) {
        const bool has_next = S.next(ui + 1, nxt);
        const char* nB = has_next ? S.btile(nxt) : cB;

        for (int t = 0; t < nt; t += 2) {
            const bool last = (t == nt - 2);
            const char* a1 = Ab + (size_t)(t + 1) * kstep;
            const char* a2 = last ? Ab : Ab + (size_t)(t + 2) * kstep; const char* b2 = last ? nB : cB + (size_t)(t + 2) * kstep;
            const char* a3 = a2 + kstep; const char* b3 = b2 + kstep;
            if (last) {
                PG8_STAGE(PG8_SA(1, 1), a1, cvo1);
                if (has_next) { PG8_AOFF(nxt, cvo0, cvo1); } PG8_SCHED; }
            PG8_LDB(B0, 0, 0); PG8_LDB(B1, 0, 1); PG8_SCHED; PG8_LDA(At, 0, 0); if (!last) PG8_STAGE(PG8_SA(1, 1), a1, cvo1);
            PG8_WAIT_V(8); PG8_WAIT_L(0); PG8_BAR; if (F8 && t == 0) { PG8_MMAZ(0, 0, At, B0); PG8_MMAZ(0, 1, At, B1); } else { PG8_MMA(0, 0, At, B0); PG8_MMA(0, 1, At, B1); } PG8_BAR; PG8_SCHED;
            PG8_LDA(At, 0, 1); PG8_STAGE(PG8_SB(0, 0), b2, voffB); PG8_STAGE(PG8_SB(0, 1), b2 + hstepB, voffB); PG8_STAGE(PG8_SA(0, 0), a2, cvo0);
            PG8_WAIT_V(8); PG8_WAIT_L(0); PG8_BAR; if (F8 && t == 0) { PG8_MMAZ(1, 0, At, B0); PG8_MMAZ(1, 1, At, B1); } else { PG8_MMA(1, 0, At, B0); PG8_MMA(1, 1, At, B1); } PG8_BAR; PG8_SCHED;
            PG8_LDB(B0, 1, 0); PG8_LDB(B1, 1, 1); PG8_SCHED; PG8_LDA(At, 1, 0); PG8_STAGE(PG8_SA(0, 1), a2, cvo1);
            PG8_WAIT_V(8); PG8_WAIT_L(0); PG8_BAR; PG8_MMA(0, 0, At, B0); PG8_MMA(0, 1, At, B1); PG8_BAR; PG8_SCHED;
            PG8_LDA(At, 1, 1); PG8_STAGE(PG8_SB(1, 0), b3, voffB); PG8_STAGE(PG8_SB(1, 1), b3 + hstepB, voffB); PG8_STAGE(PG8_SA(1, 0), a3, cvo0);
            PG8_WAIT_V(8); PG8_WAIT_L(0); PG8_BAR; PG8_MMA(1, 0, At, B0); PG8_MMA(1, 1, At, B1); PG8_BAR; PG8_SCHED;
        }
        if (wr == 0) PG8_BAR;
        if constexpr (F8) asm volatile("s_nop 15\n\ts_nop 15" ::: "memory");
        E(acc, cur, wr, wc, fr, fq);
        if (!has_next) break;
        if constexpr (!F8) {
#pragma unroll
        for (int a = 0; a < 2; ++a)
#pragma unroll
            for (int b = 0; b < 2; ++b)
#pragma unroll
                for (int m = 0; m < 4; ++m)
#pragma unroll
                    for (int n = 0; n < 2; ++n) acc[a][b][m][n] = (f32x4){0.f, 0.f, 0.f, 0.f};
        }
        cur = nxt; cB = nB; ++ui;
        if (wr == 1) PG8_BAR;
    }
    PG8_WAIT_V(0);
    PG8_BAR;
#undef PG8_AOFF
#undef PG8_SA
#undef PG8_SB
#undef PG8_STAGE
#undef PG8_LDA
#undef PG8_LDB
#undef PG8_MMA
#undef PG8_MMAZ
#undef PG8_WAIT_V
#undef PG8_WAIT_L
#undef PG8_BAR
#undef PG8_SCHED
}
}

namespace att {
constexpr int SHM_V = 64 * 128 * 2, SHM_K = 64 * 128 * 2;
constexpr int WSC_OFF = 2 * SHM_V + 2 * SHM_K;
constexpr int TAB_OFF = WSC_OFF + 8 * 256;
constexpr int RNG_OFF = TAB_OFF + 7680;
constexpr float THR = 8.f;
#define KSWZ(row, colB) ((row) * 256 + ((colB) ^ (((row) & 7) << 4)))
#define SBAR() __builtin_amdgcn_sched_barrier(0)
__device__ __forceinline__ int crow(int r, int hi) { return (r & 3) + 8 * (r >> 2) + 4 * hi; }
template <int MODE> struct Sc { static constexpr float SCALE = (MODE == 1) ? 0.125f : 0.088388347648318440f; };

template <int MODE>
__device__ __forceinline__ void partialSM(f32x16& p0, f32x16& p1, float& m_reg, float& mn, float& alpha) {
  constexpr float SCALE = Sc<MODE>::SCALE;
  constexpr float C = SCALE * 1.4426950408889634f;
  float pmax = p0[0];
#pragma unroll
  for (int r = 1; r < 16; ++r) pmax = fmaxf(pmax, p0[r]);
#pragma unroll
  for (int r = 0; r < 16; ++r) pmax = fmaxf(pmax, p1[r]);
  { auto rr = __builtin_amdgcn_permlane32_swap(__float_as_uint(pmax), __float_as_uint(pmax), false, false);
    pmax = fmaxf(__uint_as_float(rr[0]), __uint_as_float(rr[1])); }
  if (__builtin_expect(__all(pmax - m_reg <= THR / SCALE), 1)) { mn = m_reg; alpha = 1.f; }
  else { mn = fmaxf(m_reg, pmax); alpha = __builtin_amdgcn_exp2f((m_reg - mn) * C); m_reg = mn; }
  const float mnC = -mn * C;
#pragma unroll
  for (int r = 0; r < 16; ++r) p0[r] = fmaf(p0[r], C, mnC);
#pragma unroll
  for (int r = 0; r < 16; ++r) p1[r] = fmaf(p1[r], C, mnC);
#pragma unroll
  for (int r = 0; r < 16; ++r) p0[r] = __builtin_amdgcn_exp2f(p0[r]);
}
__device__ __forceinline__ void finishSM(f32x16& p0, f32x16& p1, float alpha, float& l_reg, bf16x8& pa0, bf16x8& pa1, bf16x8& pa2, bf16x8& pa3) {
#pragma unroll
  for (int r = 0; r < 16; ++r) p1[r] = __builtin_amdgcn_exp2f(p1[r]);
  float ps = 0;
#pragma unroll
  for (int r = 0; r < 16; ++r) ps += p0[r];
#pragma unroll
  for (int r = 0; r < 16; ++r) ps += p1[r];
  { auto rr = __builtin_amdgcn_permlane32_swap(__float_as_uint(ps), __float_as_uint(ps), false, false);
    ps = __uint_as_float(rr[0]) + __uint_as_float(rr[1]); }
  l_reg = l_reg * alpha + ps;
#define PK4(P, BASE, OUT) do { unsigned a0 = cvt_pk_bf16(P[BASE + 0], P[BASE + 1]), a1 = cvt_pk_bf16(P[BASE + 2], P[BASE + 3]);   \
    unsigned b0 = cvt_pk_bf16(P[BASE + 4], P[BASE + 5]), b1 = cvt_pk_bf16(P[BASE + 6], P[BASE + 7]);                              \
    auto r0 = __builtin_amdgcn_permlane32_swap(a0, b0, false, false); auto r1 = __builtin_amdgcn_permlane32_swap(a1, b1, false, false); \
    u32x4 w = {r0[0], r1[0], r0[1], r1[1]}; OUT = *reinterpret_cast<bf16x8*>(&w); } while (0)
  PK4(p0, 0, pa0); PK4(p0, 8, pa1); PK4(p1, 0, pa2); PK4(p1, 8, pa3);
#undef PK4
}
template <int NQ, bool ZERO = true>
__device__ __forceinline__ void qkt(f32x16& p0, f32x16& p1, const LAS char* Ks, const bf16x8* qr, int r32, int hi, int kcb) {
  if (ZERO) { p0 = f32x16{}; p1 = f32x16{}; }
#pragma unroll
  for (int d0 = 0; d0 < NQ; ++d0) { const int cb = kcb + (d0 * 16 + hi * 8) * 2;
    const bf16x8 b0 = *reinterpret_cast<const LAS bf16x8*>(Ks + KSWZ(r32, cb));
    const bf16x8 b1 = *reinterpret_cast<const LAS bf16x8*>(Ks + KSWZ(32 + r32, cb));
    p0 = __builtin_amdgcn_mfma_f32_32x32x16_bf16(b0, qr[d0], p0, 0, 0, 0);
    p1 = __builtin_amdgcn_mfma_f32_32x32x16_bf16(b1, qr[d0], p1, 0, 0, 0); }
}
__device__ __forceinline__ int v_st(int k, int c) { const int kk = (k & ~0xC) | ((k & 4) << 1) | ((k & 8) >> 1); return ((kk >> 3) * 4 + (c >> 5)) * 512 + ((kk & 7) * 32 + (c & 31)) * 2; }
__device__ __forceinline__ int v_rd_base(int lane) { return ((lane & 3) << 3) | (((lane >> 2) & 3) << 6) | (((lane >> 4) & 1) << 5) | (((lane >> 5) & 1) << 8); }
constexpr int v_rd_off(int d0, int ks, int half) { return d0 * 512 + ks * 4096 + half * 2048; }
template <int OFF> __device__ __forceinline__ s16x4 tr_read(int vb) {
  s16x4 r; asm volatile("ds_read_b64_tr_b16 %0, %1 offset:%2" : "=&v"(r) : "v"(vb), "i"(OFF) : "memory"); return r;
}
template <int D0> __device__ __forceinline__ void pv_one(f32x16& od, int vb, bf16x8 pa0, bf16x8 pa1, bf16x8 pa2, bf16x8 pa3) {
  const s16x4 l0 = tr_read<v_rd_off(D0, 0, 0)>(vb), h0 = tr_read<v_rd_off(D0, 0, 1)>(vb), l1 = tr_read<v_rd_off(D0, 1, 0)>(vb), h1 = tr_read<v_rd_off(D0, 1, 1)>(vb);
  const s16x4 l2 = tr_read<v_rd_off(D0, 2, 0)>(vb), h2 = tr_read<v_rd_off(D0, 2, 1)>(vb), l3 = tr_read<v_rd_off(D0, 3, 0)>(vb), h3 = tr_read<v_rd_off(D0, 3, 1)>(vb);
  asm volatile("s_waitcnt lgkmcnt(0)" ::: "memory"); SBAR();
#define PK(L, H) (bf16x8){L[0], L[1], L[2], L[3], H[0], H[1], H[2], H[3]}
  od = __builtin_amdgcn_mfma_f32_32x32x16_bf16(pa0, PK(l0, h0), od, 0, 0, 0);
  od = __builtin_amdgcn_mfma_f32_32x32x16_bf16(pa1, PK(l1, h1), od, 0, 0, 0);
  od = __builtin_amdgcn_mfma_f32_32x32x16_bf16(pa2, PK(l2, h2), od, 0, 0, 0);
  od = __builtin_amdgcn_mfma_f32_32x32x16_bf16(pa3, PK(l3, h3), od, 0, 0, 0);
#undef PK
}
__device__ __forceinline__ void pv_d0(f32x16* o, int vb, bf16x8 pa0, bf16x8 pa1, bf16x8 pa2, bf16x8 pa3) {
  pv_one<0>(o[0], vb, pa0, pa1, pa2, pa3); pv_one<1>(o[1], vb, pa0, pa1, pa2, pa3); pv_one<2>(o[2], vb, pa0, pa1, pa2, pa3); pv_one<3>(o[3], vb, pa0, pa1, pa2, pa3);
}

struct Item {
  const bf16_t* qkv;
  int tokbase, dil;
  int q0;
  int head;
  int t0, nt;
  float coef;
  bf16_t* out; int out_ld, out_col;
  float* lse;
  float lam, outscale; const float* subg; float kmax2a, kmax2b;
  const float* rpb;
};

template <int MODE>
__device__ __forceinline__ void attn_item(const Item& it, LAS char* lds) {
  constexpr float SCALE = Sc<MODE>::SCALE;
  constexpr int NQ = (MODE == 1) ? 4 : 8;
  const int tid = launder_i((int)threadIdx.x), wid = __builtin_amdgcn_readfirstlane(tid >> 6), lane = tid & 63, r32 = lane & 31, hi = lane >> 5;
  const int sub = (MODE == 1) ? (wid >> 2) : 0;
  const int wq = (MODE == 1) ? (wid & 3) : wid;
  const int q0w = it.q0 + 32 * wq;
  LAS char* V_lds = lds; LAS char* K_lds = lds + 2 * SHM_V;
  LAS float* wsc = (LAS float*)(lds + WSC_OFF) + wid * 64; LAS float* li_l = wsc; LAS float* al_l = wsc + 32;
  LAS float* tab = (LAS float*)(lds + TAB_OFF);
  const size_t rstride = (size_t)it.dil * QKVW;
  const bf16_t* base = it.qkv + (size_t)it.tokbase * QKVW;
  bf16x8 qr[NQ];
  { const bf16_t* Qw = base + (size_t)(q0w + r32) * rstride + it.head * HD + sub * 64 + hi * 8;
#pragma unroll
    for (int d0 = 0; d0 < NQ; ++d0) qr[d0] = *reinterpret_cast<const bf16x8*>(Qw + d0 * 16); }
  float m_reg = -1e30f, l_reg = 0.f; f32x16 o[4] = {};
  int t_first = it.t0, n_tiles = it.nt;
  bool nomax = false;
  if (MODE == 1) {
    constexpr float C = SCALE * 1.4426950408889634f;
    const bf16_t* Kw = base + (size_t)(q0w + r32) * rstride + DM + it.head * HD + sub * 64 + hi * 8;
    float qq = 0.f, qk = 0.f;
#pragma unroll
    for (int d0 = 0; d0 < NQ; ++d0) { const bf16x8 kf = *reinterpret_cast<const bf16x8*>(Kw + d0 * 16);
#pragma unroll
      for (int e = 0; e < 8; ++e) { const float qf = bf2f((unsigned short)qr[d0][e]), kv = bf2f((unsigned short)kf[e]); qq = fmaf(qf, qf, qq); qk = fmaf(qf, kv, qk); } }
    { auto r0 = __builtin_amdgcn_permlane32_swap(__float_as_uint(qq), __float_as_uint(qq), false, false); qq = __uint_as_float(r0[0]) + __uint_as_float(r0[1]);
      auto r1 = __builtin_amdgcn_permlane32_swap(__float_as_uint(qk), __float_as_uint(qk), false, false); qk = __uint_as_float(r1[0]) + __uint_as_float(r1[1]); }
    const float kmx = sqrtf(sub ? it.kmax2b : it.kmax2a), qn = sqrtf(qq);
    const float R = (qn * kmx * 1.01f + 152.0f + C - qk) / (it.coef * C);
    m_reg = qk + 8.0f;
    nomax = __all(qn * kmx - m_reg <= 100.0f);
    const int Ri = (int)fminf(R, 1.0e6f) + 2;
    int lo = q0w + r32 - Ri, hi2 = q0w + r32 + Ri;
#pragma unroll
    for (int off = 1; off < 64; off <<= 1) { lo = min(lo, shx(lo, off)); hi2 = max(hi2, shx(hi2, off)); }
    LAS int* rng = (LAS int*)(lds + RNG_OFF);
    __syncthreads();
    if (tid == 0) { rng[0] = launder_i(0x7fffffff); rng[1] = launder_i(-0x7fffffff); }
    __syncthreads();
    if (lane == 0) { __hip_atomic_fetch_min(&rng[0], lo, __ATOMIC_RELAXED, __HIP_MEMORY_SCOPE_WORKGROUP); __hip_atomic_fetch_max(&rng[1], hi2, __ATOMIC_RELAXED, __HIP_MEMORY_SCOPE_WORKGROUP); }
    __syncthreads();
    int tlo = rng[0] >> 6, thi = rng[1] >> 6;
    tlo = tlo < it.t0 ? it.t0 : tlo; thi = thi > it.t0 + it.nt - 1 ? it.t0 + it.nt - 1 : thi;
    t_first = tlo; n_tiles = thi - tlo + 1;
  }
  const int sr = tid >> 4, sc = (tid & 15) * 8, vst0 = v_st(sr, sc), vst1 = v_st(32 + sr, sc);
  const int vb0 = (int)(unsigned)(uintptr_t)V_lds + v_rd_base(lane);
  const bf16_t* Kg = base + DM + it.head * HD + sc;
  const bf16_t* Vg = base + 2 * DM + it.head * HD + sc;
  bf16x8 vs0, vs1, ks0, ks1;
#define SLOAD(t) do { const size_t r0_ = (size_t)(64 * (t) + sr) * rstride, r1_ = r0_ + 32 * rstride; \
    vs0 = *reinterpret_cast<const bf16x8*>(Vg + r0_); vs1 = *reinterpret_cast<const bf16x8*>(Vg + r1_); \
    ks0 = *reinterpret_cast<const bf16x8*>(Kg + r0_); ks1 = *reinterpret_cast<const bf16x8*>(Kg + r1_); } while (0)
#define SWRITE(b) do { *reinterpret_cast<LAS bf16x8*>(V_lds + (b) * SHM_V + vst0) = vs0; *reinterpret_cast<LAS bf16x8*>(V_lds + (b) * SHM_V + vst1) = vs1; const int kc_ = sc * 2; \
    *reinterpret_cast<LAS bf16x8*>(K_lds + (b) * SHM_K + KSWZ(sr, kc_)) = ks0; *reinterpret_cast<LAS bf16x8*>(K_lds + (b) * SHM_K + KSWZ(32 + sr, kc_)) = ks1; } while (0)
  __syncthreads();
  if (MODE == 2) {
    for (int i = tid; i < 15 * 128; i += 512) { const int dr = i >> 7, dc = (i & 127) - 48; tab[i] = (dc >= 0 && dc < 31) ? it.rpb[dr * 31 + dc] * (1.0f / SCALE) : 0.f; }
  }
  if constexpr (MODE == 1) {
#define SLOADK(t) do { const size_t r0_ = (size_t)(64 * (t) + sr) * rstride; ks0 = *reinterpret_cast<const bf16x8*>(Kg + r0_); ks1 = *reinterpret_cast<const bf16x8*>(Kg + r0_ + 32 * rstride); } while (0)
#define SLOADV(t) do { const size_t r0_ = (size_t)(64 * (t) + sr) * rstride; vs0 = *reinterpret_cast<const bf16x8*>(Vg + r0_); vs1 = *reinterpret_cast<const bf16x8*>(Vg + r0_ + 32 * rstride); } while (0)
#define SWRITEK(b) do { const int kc_ = sc * 2; *reinterpret_cast<LAS bf16x8*>(K_lds + (b) * SHM_K + KSWZ(sr, kc_)) = ks0; *reinterpret_cast<LAS bf16x8*>(K_lds + (b) * SHM_K + KSWZ(32 + sr, kc_)) = ks1; } while (0)
#define SWRITEV(b) do { *reinterpret_cast<LAS bf16x8*>(V_lds + (b) * SHM_V + vst0) = vs0; *reinterpret_cast<LAS bf16x8*>(V_lds + (b) * SHM_V + vst1) = vs1; } while (0)
#define QKB(P0, P1, MR, t, kb) do { const float dq_ = (float)(q0w + r32 - 64 * (t) - 4 * hi); MR = m_reg; \
    if (64 * (t) + 63 <= q0w) { const float k_ = -cfc * dq_ - m_reg; \
      _Pragma("unroll") for (int r = 0; r < 16; ++r) { const float c_ = (float)((r & 3) + 8 * (r >> 2)); P0[r] = fmaf(cfc, c_, k_); P1[r] = fmaf(cfc, c_ + 32.f, k_); } } \
    else if (64 * (t) >= q0w + 31) { const float k_ = cfc * dq_ - m_reg; \
      _Pragma("unroll") for (int r = 0; r < 16; ++r) { const float c_ = (float)((r & 3) + 8 * (r >> 2)); P0[r] = fmaf(-cfc, c_, k_); P1[r] = fmaf(-cfc, c_ + 32.f, k_); } } \
    else { const float nm_ = -m_reg; _Pragma("unroll") for (int r = 0; r < 16; ++r) { const float c_ = (float)((r & 3) + 8 * (r >> 2)); P0[r] = fmaf(-cfc, fabsf(dq_ - c_), nm_); P1[r] = fmaf(-cfc, fabsf(dq_ - c_ - 32.f), nm_); } } \
    qkt<NQ, false>(P0, P1, K_lds + (kb) * SHM_K, qr, r32, hi, sub * 128); } while (0)
#define SMPV(P0, P1, MR, vbuf) do { float alpha_ = 1.f; bf16x8 pa0, pa1, pa2, pa3; \
    if (!nomax) { \
    float pm_ = P0[0]; _Pragma("unroll") for (int r = 1; r < 16; ++r) pm_ = fmaxf(pm_, P0[r]); _Pragma("unroll") for (int r = 0; r < 16; ++r) pm_ = fmaxf(pm_, P1[r]); \
    { auto rr_ = __builtin_amdgcn_permlane32_swap(__float_as_uint(pm_), __float_as_uint(pm_), false, false); pm_ = fmaxf(__uint_as_float(rr_[0]), __uint_as_float(rr_[1])); } \
    const float sh_ = m_reg - MR; \
    if (__builtin_expect(!__all(pm_ <= THRL && sh_ == 0.f), 0)) { const float dl_ = fmaxf(pm_ - sh_, 0.f), sub_ = sh_ + dl_; alpha_ = __builtin_amdgcn_exp2f(-dl_); m_reg += dl_; \
      _Pragma("unroll") for (int r = 0; r < 16; ++r) { P0[r] -= sub_; P1[r] -= sub_; } \
      if (__any(alpha_ < 1.f)) { if (hi == 0) al_l[r32] = alpha_; asm volatile("s_waitcnt lgkmcnt(0)" ::: "memory"); \
        _Pragma("unroll") for (int d = 0; d < 4; ++d) _Pragma("unroll") for (int r = 0; r < 16; ++r) o[d][r] *= al_l[crow(r, hi)]; } } } \
    _Pragma("unroll") for (int r = 0; r < 16; ++r) P0[r] = __builtin_amdgcn_exp2f(P0[r]); \
    finishSM(P0, P1, alpha_, l_reg, pa0, pa1, pa2, pa3); SBAR(); pv_d0(o, vb0 + (vbuf) * SHM_V, pa0, pa1, pa2, pa3); } while (0)
#define BSTEP(j, C0, C1, CM, N0, N1, NM, CB, NB) do { __syncthreads(); \
    if ((j) + 2 < T) SLOADK(t_first + (j) + 2); if ((j) + 1 < T) SLOADV(t_first + (j) + 1); \
    if ((j) + 1 < T) QKB(N0, N1, NM, t_first + (j) + 1, NB); SBAR(); \
    SMPV(C0, C1, CM, CB); \
    if ((j) + 2 < T) SWRITEK(CB); if ((j) + 1 < T) SWRITEV(NB); } while (0)
    const int T = n_tiles;
    SLOADK(t_first); SLOADV(t_first); SWRITEK(0); SWRITEV(0);
    if (T > 1) { SLOADK(t_first + 1); SWRITEK(1); }
    __syncthreads();
    f32x16 pA0, pA1, pB0, pB1; float mrA, mrB = 0.f;
    constexpr float THRL = THR * 1.4426950408889634f;
    const float cfc = it.coef * (SCALE * 1.4426950408889634f);
    QKB(pA0, pA1, mrA, t_first, 0);
    for (int j = 0; j < T; j += 2) {
      BSTEP(j, pA0, pA1, mrA, pB0, pB1, mrB, 0, 1);
      if (j + 1 < T) BSTEP(j + 1, pB0, pB1, mrB, pA0, pA1, mrA, 1, 0);
    }
#undef SLOADK
#undef SLOADV
#undef SWRITEK
#undef SWRITEV
#undef QKB
#undef SMPV
#undef BSTEP
  } else {
  struct Stg { bf16x8 v0, v1, k0, k1; } sA, sB;
#define SLD(S, t) do { const size_t r0_ = (size_t)(64 * (t) + sr) * rstride, r1_ = r0_ + 32 * rstride; \
    S.v0 = *reinterpret_cast<const bf16x8*>(Vg + r0_); S.v1 = *reinterpret_cast<const bf16x8*>(Vg + r1_); S.k0 = *reinterpret_cast<const bf16x8*>(Kg + r0_); S.k1 = *reinterpret_cast<const bf16x8*>(Kg + r1_); } while (0)
#define SWR(S, b) do { *reinterpret_cast<LAS bf16x8*>(V_lds + (b) * SHM_V + vst0) = S.v0; *reinterpret_cast<LAS bf16x8*>(V_lds + (b) * SHM_V + vst1) = S.v1; const int kc_ = sc * 2; \
    *reinterpret_cast<LAS bf16x8*>(K_lds + (b) * SHM_K + KSWZ(sr, kc_)) = S.k0; *reinterpret_cast<LAS bf16x8*>(K_lds + (b) * SHM_K + KSWZ(32 + sr, kc_)) = S.k1; } while (0)
  SLD(sA, t_first); SWR(sA, 0);
  if (n_tiles > 1) SLD(sB, t_first + 1);
  const int rq = (MODE == 2) ? (it.q0 >> 6) + (wid >> 1) : 0;
  const int cq = (MODE == 2) ? 32 * (wid & 1) + r32 : 0;
  const int rs = (MODE == 2) ? (rq - 4 < 0 ? 0 : (rq - 4 > 56 ? 56 : rq - 4)) : 0;
  const int cst = (MODE == 2) ? (cq - 8 < 0 ? 0 : (cq - 8 > 48 ? 48 : cq - 8)) : 0;
  for (int j0 = 0; j0 < n_tiles; j0 += 2) {
#pragma unroll
   for (int hf = 0; hf < 2; ++hf) {
    const int j = j0 + hf; if (j >= n_tiles) break;
    const int t = t_first + j, buf = hf;
    __syncthreads();
    if (j + 2 < n_tiles) { if (hf == 0) SLD(sA, t + 2); else SLD(sB, t + 2); }
    bool rel;
    if (MODE == 0) rel = (64 * t + 63 >= q0w - 64) && (64 * t <= q0w + 31 + 64);
    else if (MODE == 1) rel = true;
    else rel = (t >= rs) && (t <= rs + 7);
    if (rel) {
      f32x16 p0, p1; float mn, alpha; bf16x8 pa0, pa1, pa2, pa3;
      if (MODE == 0) {
        const float dq = (float)(q0w + r32 - 64 * t - 4 * hi);
        if (64 * t + 63 < q0w) { const float k_ = -it.coef * dq, lim = dq - 64.f;
#pragma unroll
          for (int r = 0; r < 16; ++r) { const float c = (float)((r & 3) + 8 * (r >> 2));
            p0[r] = c >= lim ? fmaf(it.coef, c, k_) : -1e30f; p1[r] = c + 32.f >= lim ? fmaf(it.coef, c + 32.f, k_) : -1e30f; } }
        else if (64 * t > q0w + 31) { const float k_ = it.coef * dq, lim = dq + 64.f;
#pragma unroll
          for (int r = 0; r < 16; ++r) { const float c = (float)((r & 3) + 8 * (r >> 2));
            p0[r] = c <= lim ? fmaf(-it.coef, c, k_) : -1e30f; p1[r] = c + 32.f <= lim ? fmaf(-it.coef, c + 32.f, k_) : -1e30f; } }
        else {
#pragma unroll
          for (int r = 0; r < 16; ++r) { const float c = (float)((r & 3) + 8 * (r >> 2)); p0[r] = -it.coef * fabsf(dq - c); p1[r] = -it.coef * fabsf(dq - c - 32.f); } }
        qkt<NQ, false>(p0, p1, K_lds + buf * SHM_K, qr, r32, hi, sub * 128);
      } else {
        qkt<NQ>(p0, p1, K_lds + buf * SHM_K, qr, r32, hi, sub * 128);
        const int dr = t - rq + 7;
        int kb = launder_i(4 * hi - cst);
        const LAS float* trow = tab + dr * 128 + 48 + 15 + 4 * hi - cq;
#pragma unroll
        for (int r = 0; r < 16; ++r) { const int c0 = (r & 3) + 8 * (r >> 2);
          const bool ok0 = (unsigned)(kb + c0) < 16u, ok1 = (unsigned)(kb + c0 + 32) < 16u;
          const float b0 = trow[c0], b1 = trow[c0 + 32];
          p0[r] = ok0 ? p0[r] + b0 : -1e30f; p1[r] = ok1 ? p1[r] + b1 : -1e30f; }
      }
      partialSM<MODE>(p0, p1, m_reg, mn, alpha);
      if (__any(alpha < 1.f)) { if (hi == 0) al_l[r32] = alpha; asm volatile("s_waitcnt lgkmcnt(0)" ::: "memory");
#pragma unroll
        for (int d = 0; d < 4; ++d)
#pragma unroll
          for (int r = 0; r < 16; ++r) o[d][r] *= al_l[crow(r, hi)]; }
      finishSM(p0, p1, alpha, l_reg, pa0, pa1, pa2, pa3); SBAR();
      pv_d0(o, vb0 + buf * SHM_V, pa0, pa1, pa2, pa3);
    }
    if (j + 1 < n_tiles) { if (hf == 0) SWR(sB, 1); else SWR(sA, 0); }
   }
  }
#undef SLD
#undef SWR
  }
#undef SLOAD
#undef SWRITE
  if (hi == 0) li_l[r32] = l_reg;
  asm volatile("s_waitcnt lgkmcnt(0)" ::: "memory");
  float rli[16];
#pragma unroll
  for (int r = 0; r < 16; ++r) rli[r] = __builtin_amdgcn_rcpf(li_l[crow(r, hi)]);
  if (MODE == 0 || MODE == 2) {
#pragma unroll
    for (int r = 0; r < 16; ++r) { const int tok = it.tokbase + (q0w + crow(r, hi)) * it.dil;
      if (MODE == 0) { bf16_t* dst = it.out + (size_t)tok * it.out_ld + it.out_col + r32;
#pragma unroll
        for (int d0 = 0; d0 < 4; ++d0) dst[d0 * 32] = (bf16_t)(cvt_pk_bf16(o[d0][r] * rli[r], 0.f) & 0xffffu); }
      else { unsigned char* dst = (unsigned char*)it.out + (size_t)tok * it.out_ld + it.out_col + r32;
#pragma unroll
        for (int d0 = 0; d0 < 4; ++d0) { const float x = o[d0][r] * rli[r]; dst[d0 * 32] = (unsigned char)(pk4_fp8(x, x, x, x) & 0xffu); } } }
    if (MODE == 0 && hi == 0) { const int tok = it.tokbase + (q0w + r32) * it.dil; it.lse[(size_t)tok * 8 + it.head] = m_reg * SCALE + __logf(l_reg); }
  } else {
    __syncthreads();
    LAS float* ex = (LAS float*)lds + (size_t)(wid & 3) * 4096;
    if (sub == 1) {
#pragma unroll
      for (int d0 = 0; d0 < 4; ++d0)
#pragma unroll
        for (int r = 0; r < 16; ++r) ex[(d0 * 16 + r) * 64 + lane] = o[d0][r] * rli[r] * it.lam;
    }
    __syncthreads();
    if (sub == 0) {
      float ss[16];
#pragma unroll
      for (int r = 0; r < 16; ++r) { float s = 0.f;
#pragma unroll
        for (int d0 = 0; d0 < 4; ++d0) { const float v = o[d0][r] * rli[r] - ex[(d0 * 16 + r) * 64 + lane]; o[d0][r] = v; s += v * v; }
        ss[r] = s; }
#pragma unroll
      for (int r = 0; r < 16; ++r) { float s = ss[r];
s = row_sum16(s); s += shx(s, 16);
        ss[r] = __builtin_amdgcn_rsqf(s * (1.0f / 128.0f) + SUBLN_EPS) * it.outscale; }
      float gcol[4];
#pragma unroll
      for (int d0 = 0; d0 < 4; ++d0) gcol[d0] = it.subg[d0 * 32 + r32];
#pragma unroll
      for (int r = 0; r < 16; ++r) { const int tok = it.tokbase + (q0w + crow(r, hi)) * it.dil; unsigned char* dst = (unsigned char*)it.out + (size_t)tok * it.out_ld + it.out_col + r32;
#pragma unroll
        for (int d0 = 0; d0 < 4; ++d0) { const float x = o[d0][r] * ss[r] * gcol[d0]; dst[d0 * 32] = (unsigned char)(pk4_fp8(x, x, x, x) & 0xffu); } }
    }
  }
}
}

struct Args { const float* in[23]; float* out; unsigned char* ws; int ph_lo, ph_hi; };
enum { I_X = 0, I_C, I_ADAW, I_ADAB, I_GMIX, I_GFFN, I_WIN, I_LQ1, I_LK1, I_LQ2, I_LK2, I_SUBG, I_RPB, I_WOUT, I_RW, I_RB, I_EG, I_EU, I_ED, I_SG, I_SU, I_SD, I_FG };
struct Frame { LAS unsigned char* lds; int tid, lane, wave, vcu, G; };
__device__ __forceinline__ Frame relaunder(const Frame& F0) { Frame F = F0; F.tid = launder_i((int)threadIdx.x); F.lane = F.tid & 63; F.wave = __builtin_amdgcn_readfirstlane(F.tid >> 6); return F; }
constexpr int N_PHASES = 2 + 8 * NLAYER;

__device__ __forceinline__ int gu_row(int j, int type) { return ((j >> 5) << 6) + (type << 5) + (j & 31); }
__device__ __forceinline__ void transpose_item(const float* __restrict__ W, int K, int N, bf16_t* __restrict__ WT, int mode, LAS float* scr, int item, int lane) {
    const int nblk = N >> 5, kb = item / nblk, nb = item - kb * nblk, k0 = 64 * kb, n0 = 32 * nb;
    float v[32];
    const float* src = W + (size_t)(k0 + (lane >> 5)) * N + n0 + (lane & 31);
#pragma unroll
    for (int i = 0; i < 32; ++i) v[i] = src[(size_t)(2 * i) * N];
#pragma unroll
    for (int i = 0; i < 32; ++i) scr[(2 * i + (lane >> 5)) * 33 + (lane & 31)] = v[i];
    LDS_WAIT();
    const int c = lane & 7;
#pragma unroll
    for (int j = 0; j < 4; ++j) { const int n = (lane >> 3) + 8 * j; const LAS float* s = scr + (8 * c) * 33 + n;
        u32x4 o; o.x = cvt_pk_bf16(s[0 * 33], s[1 * 33]); o.y = cvt_pk_bf16(s[2 * 33], s[3 * 33]); o.z = cvt_pk_bf16(s[4 * 33], s[5 * 33]); o.w = cvt_pk_bf16(s[6 * 33], s[7 * 33]);
        const int jn = n0 + n, drow = mode == 0 ? jn : gu_row(jn, mode - 1);
        *(u32x4*)(WT + (size_t)drow * K + k0 + 8 * c) = o; }
    LDS_WAIT();
}
struct CvtItem { const float* src; unsigned char* dst; int K, N, mode, item; };
__device__ __forceinline__ void tf8_load(const CvtItem& c, int lane, f32x4 (&v)[8]) {
    const int nblk = c.N >> 5, kb = c.item / nblk, nb = c.item - kb * nblk, k0 = 64 * kb, n0 = 32 * nb;
    const float* src = c.src + (size_t)(k0 + 8 * (lane >> 3)) * c.N + n0 + 4 * (lane & 7);
#pragma unroll
    for (int i = 0; i < 8; ++i) v[i] = __builtin_nontemporal_load((const f32x4*)(src + (size_t)i * c.N));
}
__device__ __forceinline__ void tf8_store(const CvtItem& c, int lane, LAS float* scr, const f32x4 (&v)[8]) {
    const int nblk = c.N >> 5, kb = c.item / nblk, nb = c.item - kb * nblk, k0 = 64 * kb, n0 = 32 * nb;
    LAS unsigned char* img = (LAS unsigned char*)scr;
    const int kg = lane >> 3, cc = lane & 7;
#pragma unroll
    for (int t = 0; t < 4; ++t) { u32x2 w;
        w.x = pk4_fp8w(v[0][t] * 32.f, v[1][t] * 32.f, v[2][t] * 32.f, v[3][t] * 32.f); w.y = pk4_fp8w(v[4][t] * 32.f, v[5][t] * 32.f, v[6][t] * 32.f, v[7][t] * 32.f);
        *(LAS u32x2*)(img + (4 * cc + t) * 72 + 8 * kg) = w; }
    LDS_WAIT();
    const int n = lane >> 1, kh = (lane & 1) * 32;
    const LAS unsigned char* rp = img + n * 72 + kh;
    const u32x2 a0 = *(const LAS u32x2*)(rp), a1 = *(const LAS u32x2*)(rp + 8), a2 = *(const LAS u32x2*)(rp + 16), a3 = *(const LAS u32x2*)(rp + 24);
    const int jn = n0 + n, drow = c.mode == 0 ? jn : gu_row(jn, c.mode - 1);
    unsigned char* dst = c.dst + (size_t)drow * c.K + k0 + kh;
    u32x4 o0, o1; o0.x = a0.x; o0.y = a0.y; o0.z = a1.x; o0.w = a1.y; o1.x = a2.x; o1.y = a2.y; o1.z = a3.x; o1.w = a3.y;
    *(u32x4*)dst = o0; *(u32x4*)(dst + 16) = o1;
    LDS_WAIT();
}
__device__ __forceinline__ void ph_prologue(const Args& a, const Frame& F0) {
    const Frame F = relaunder(F0);
    unsigned char* ws = a.ws + opq0();
    float* mod = (float*)(ws + WS_MOD);
    LAS float* sc_s = (LAS float*)F.lds;
    LAS float* red = (LAS float*)(F.lds + 32768);
    for (int i = F.tid; i < NBATCH * DM; i += 512) { const float v = a.in[I_C][i]; sc_s[i] = v / (1.0f + __expf(-v)); }
    __syncthreads();
    for (int u = F.vcu; u < NLAYER * 96; u += F.G) {
        const int l = u / 96, n0 = (u % 96) * 128, cg = F.tid & 31, ks = F.tid >> 5;
        const float* W = a.in[I_ADAW] + (size_t)l * DM * MODW + n0 + 4 * cg;
        f32x4 acc[4] = {};
#pragma unroll 16
        for (int it = 0; it < 128; ++it) { const int k = ks + 16 * it; const f32x4 w = __builtin_nontemporal_load((const f32x4*)(W + (size_t)k * MODW));
#pragma unroll
            for (int b = 0; b < 4; ++b) acc[b] += sc_s[b * DM + k] * w; }
#pragma unroll
        for (int b = 0; b < 4; ++b) *(LAS f32x4*)(red + ((ks * 4 + b) * 128 + 4 * cg)) = acc[b];
        __syncthreads();
        { const int b = F.tid >> 7, col = F.tid & 127; float s = 0.f;
#pragma unroll
          for (int k2 = 0; k2 < 16; ++k2) s += red[(k2 * 4 + b) * 128 + col];
          mod[(size_t)(l * 4 + b) * MODW + n0 + col] = s + a.in[I_ADAB][l * MODW + n0 + col]; }
        __syncthreads();
    }
    if (blockIdx.x == 0 && F.tid < NLAYER) { const int l = F.tid; float s1 = 0.f, s2 = 0.f;
        for (int i = 0; i < 64; ++i) { s1 += a.in[I_LQ1][l * 64 + i] * a.in[I_LK1][l * 64 + i]; s2 += a.in[I_LQ2][l * 64 + i] * a.in[I_LK2][l * 64 + i]; }
        const float li = 0.8f - 0.6f * expf(-0.3f * (float)l);
        mod[NLAYER * NBATCH * MODW + l] = expf(s1) - expf(s2) + li; }
    {
        bf16_t* wrh = (bf16_t*)(ws + WS_WRH); bf16_t* wrl = (bf16_t*)(ws + WS_WRL);
        for (int i = F.vcu * 512 + F.tid; i < NLAYER * NE * DM; i += F.G * 512) { const int l = i / (NE * DM), r = i - l * NE * DM, e = r / DM, k = r - e * DM;
            const float w = a.in[I_RW][(size_t)l * DM * NE + (size_t)k * NE + e]; const unsigned hi = cvt_pk_bf16(w, 0.f) & 0xffffu; const float lo = w - __uint_as_float(hi << 16);
            wrh[i] = (bf16_t)hi; wrl[i] = (bf16_t)(cvt_pk_bf16(lo, 0.f) & 0xffffu); }
    }
    __syncthreads();
    LAS float* scr = (LAS float*)(F.lds + F.wave * 16384);
    const int gw = F.vcu * 8 + F.wave, NGW = F.G * 8;
    constexpr int I_IN = 32 * 192;
    for (int it = gw; it < I_IN; it += NGW) {
        CvtItem c; c.src = a.in[I_WIN]; c.dst = (unsigned char*)(ws + WS_WIN); c.K = DM; c.N = QKVW; c.mode = 0; c.item = it; f32x4 v[8]; tf8_load(c, F.lane, v); tf8_store(c, F.lane, scr, v);
    }
}
constexpr int CONV_ITEMS = 3 * NEX * 512, CONV_CHUNK = 64, CONV_NCHUNK = (CONV_ITEMS + CONV_CHUNK - 1) / CONV_CHUNK;
constexpr int CONV_XOUT = 32 * 64, CONV_XIN = 32 * 192, CONV_EXTRA = 2 * CONV_XOUT + CONV_XIN;
constexpr int CONV_NCHUNK0 = (CONV_ITEMS + CONV_EXTRA + CONV_CHUNK - 1) / CONV_CHUNK;
__device__ __forceinline__ CvtItem conv_expert_desc(const Args& a, int l, int r) {
    unsigned char* ws = a.ws; constexpr int I_E = 512; CvtItem c;
    const int total = CONV_ITEMS + (l == 0 ? CONV_EXTRA : 0);
    if (r >= total) r = total - 1;
    if (r >= CONV_ITEMS) {
        r -= CONV_ITEMS; c.K = DM; c.mode = 0;
        if (r < CONV_XOUT) { c.src = a.in[I_WOUT]; c.dst = (unsigned char*)(ws + WS_WOUT); c.N = DM; c.item = r; return c; } r -= CONV_XOUT;
        if (r < CONV_XIN) { c.src = a.in[I_WIN] + (size_t)DM * QKVW; c.dst = (unsigned char*)(ws + WS_WIN) + (size_t)QKVW * DM; c.N = QKVW; c.item = r; return c; } r -= CONV_XIN;
        c.src = a.in[I_WOUT] + (size_t)DM * DM; c.dst = (unsigned char*)(ws + WS_WOUT) + (size_t)DM * DM; c.N = DM; c.item = r; return c;
    }
    const int seg = r / (NEX * I_E); r -= seg * NEX * I_E; const int e = r / I_E; c.item = r - e * I_E;
    if (seg < 2) { c.src = e < NE ? a.in[seg == 0 ? I_EG : I_EU] + (size_t)(l * NE + e) * DM * EDIM : a.in[seg == 0 ? I_SG : I_SU] + (size_t)l * DM * EDIM;
        c.K = DM; c.N = EDIM; c.dst = (unsigned char*)(ws + WS_WGU) + (size_t)(l * NEX + e) * 1024 * DM; c.mode = 1 + seg; }
    else { c.src = e < NE ? a.in[I_ED] + (size_t)(l * NE + e) * EDIM * DM : a.in[I_SD] + (size_t)l * EDIM * DM;
        c.K = EDIM; c.N = DM; c.dst = (unsigned char*)(ws + WS_WD) + (size_t)(l * NEX + e) * DM * EDIM; c.mode = 0; }
    return c;
}
__device__ __forceinline__ int queue_pull(unsigned* q, volatile LAS int* slot, int tid) {
    if (tid == 0) *slot = (int)xb_add(q, 1u);
    __syncthreads();
    const int v = *slot;
    __syncthreads();
    return v;
}

__device__ __forceinline__ void ph_norm(const Frame& F0, const float* __restrict__ src, const float* __restrict__ gvec, const float* __restrict__ modl, int sh_off, int sc_off, bf16_t* __restrict__ dst) {
    const Frame F = relaunder(F0);
    const int gw = F.vcu * 8 + F.wave, NGW = F.G * 8;
    for (int chunk = gw; chunk < NTOK / 8; chunk += NGW) {
        const int row0 = chunk * 8, b = row0 / SEQ;
        f32x4 Gv[8], Sv[8];
#pragma unroll
        for (int j = 0; j < 8; ++j) { const int col = 4 * F.lane + 256 * j; const f32x4 g4 = *(const f32x4*)(gvec + col), s4 = *(const f32x4*)(modl + (size_t)b * MODW + sc_off + col);
            Gv[j] = g4 * (1.0f + s4); Sv[j] = *(const f32x4*)(modl + (size_t)b * MODW + sh_off + col); }
        f32x4 nx[8];
#pragma unroll
        for (int j = 0; j < 8; ++j) nx[j] = *(const f32x4*)(src + (size_t)row0 * DM + 4 * F.lane + 256 * j);
        for (int rr = 0; rr < 8; ++rr) {
            const float* xr = src + (size_t)(row0 + rr + (rr < 7 ? 1 : 0)) * DM + 4 * F.lane;
            f32x4 v[8]; float ss = 0.f;
#pragma unroll
            for (int j = 0; j < 8; ++j) { v[j] = nx[j]; nx[j] = *(const f32x4*)(xr + 256 * j); ss += (v[j].x * v[j].x + v[j].y * v[j].y) + (v[j].z * v[j].z + v[j].w * v[j].w); }
            const float rstd = __builtin_amdgcn_rsqf(wave_sum(ss) * (1.0f / DM) + NORM_EPS);
            unsigned char* orow = (unsigned char*)dst + (size_t)(row0 + rr) * DM + 4 * F.lane;
#pragma unroll
            for (int j = 0; j < 8; ++j) { const f32x4 h = v[j] * rstd * Gv[j] + Sv[j]; *(unsigned*)(orow + 256 * j) = pk4_fp8(h.x, h.y, h.z, h.w); }
        }
    }
}

__device__ __forceinline__ void ph_attention1(const Args& a, const Frame& F0, int l, int qrep = 0) {
    const Frame F = relaunder(F0);
    unsigned char* ws = a.ws + opq0();
    const bf16_t* qkv = (const bf16_t*)(ws + WS_QKV);
    unsigned* ctl = (unsigned*)(ws + WS_CTL);
    LAS char* lds = (LAS char*)F.lds;
    {
        LAS unsigned* kmx = (LAS unsigned*)(F.lds + att::RNG_OFF + 64);
        for (int chunk = F.vcu; chunk < NTOK / 64; chunk += F.G) {
            if (F.tid < 8) kmx[F.tid] = 0u;
            __syncthreads();
            const int tl = F.tid >> 3, part = F.tid & 7, tok = chunk * 64 + tl, b = tok / SEQ;
            const bf16_t* kp = qkv + (size_t)tok * QKVW + DM + (8 + (part >> 1)) * HD + (part & 1) * 64;
            float ss = 0.f;
#pragma unroll
            for (int i = 0; i < 8; ++i) { const u32x4 x = *(const u32x4*)(kp + 8 * i);
                ss += bflo(x.x) * bflo(x.x) + bfhi(x.x) * bfhi(x.x) + bflo(x.y) * bflo(x.y) + bfhi(x.y) * bfhi(x.y) + bflo(x.z) * bflo(x.z) + bfhi(x.z) * bfhi(x.z) + bflo(x.w) * bflo(x.w) + bfhi(x.w) * bfhi(x.w); }
            __hip_atomic_fetch_max(&kmx[part], __float_as_uint(ss), __ATOMIC_RELAXED, __HIP_MEMORY_SCOPE_WORKGROUP);
            __syncthreads();
            if (F.tid < 8) __hip_atomic_fetch_max(ctl + CW_KMAX + ((l * NBATCH + b) * 4 + (F.tid >> 1)) * 2 + (F.tid & 1), kmx[F.tid], __ATOMIC_RELAXED, __HIP_MEMORY_SCOPE_AGENT);
            __syncthreads();
        }
    }
    volatile LAS int* qslot = (volatile LAS int*)(F.lds + MISC_OFF + 16);
    const bool conv_first = (F.vcu & 7) < 4;
    for (int pass = 0; pass < 2; ++pass) {
        if ((pass == 0) == conv_first) {
            LAS float* scr = (LAS float*)(F.lds + F.wave * 16384);
            for (;;) {
                const int c = queue_pull(ctl + CW_QV + 64 * l + 8 * qrep, qslot, F.tid);
                if (c >= (l == 0 ? CONV_NCHUNK0 : CONV_NCHUNK)) break;
                const int r0 = c * CONV_CHUNK + F.wave * (CONV_CHUNK / 8);
                f32x4 va[8], vb[8], vc[8], vd[8];
                int NI = CONV_CHUNK / 8; asm volatile("" : "+s"(NI));
#define CV_LOAD(k, V) tf8_load(conv_expert_desc(a, l, r0 + (k)), F.lane, V)
#define CV_STORE(k, V) tf8_store(conv_expert_desc(a, l, r0 + (k)), F.lane, scr, V)
                CV_LOAD(0, va); CV_LOAD(1, vb); CV_LOAD(2, vc);
#pragma unroll 1
                for (int k = 0; k < NI; k += 4) {
                    CV_LOAD(k + 3, vd); CV_STORE(k, va);
                    if (k + 4 < NI) CV_LOAD(k + 4, va); CV_STORE(k + 1, vb);
                    if (k + 5 < NI) CV_LOAD(k + 5, vb); CV_STORE(k + 2, vc);
                    if (k + 6 < NI) CV_LOAD(k + 6, vc); CV_STORE(k + 3, vd);
                }
#undef CV_LOAD
#undef CV_STORE
            }
        } else {
            for (;;) {
                const int idx = queue_pull(ctl + CW_QC2 + 64 * l + 8 * qrep, qslot, F.tid);
                if (idx >= 256) break;
                const int b = idx >> 6, h = (idx >> 4) & 3, qb = idx & 15;
                att::Item it{}; it.qkv = qkv; it.tokbase = b * SEQ; it.dil = 1; it.q0 = 256 * qb; it.head = 12 + h;
                int t0 = 4 * qb - 4; t0 = t0 < 0 ? 0 : (t0 > 56 ? 56 : t0); int te = 4 * qb + 3 - 4; te = te < 0 ? 0 : (te > 56 ? 56 : te); te += 7;
                it.t0 = t0; it.nt = te - t0 + 1; it.coef = 0.f;
                it.out = (bf16_t*)(ws + WS_OCAT); it.out_ld = DM; it.out_col = (12 + h) * HD; it.lse = nullptr;
                it.lam = 0.f; it.outscale = 0.f; it.subg = nullptr; it.rpb = a.in[I_RPB] + (size_t)(l * 4 + h) * 15 * 31;
                att::attn_item<2>(it, lds);
            }
            for (;;) {
                const int idx = queue_pull(ctl + CW_QA + 64 * l + 8 * qrep, qslot, F.tid);
                if (idx >= 1536) break;
                const int bh = idx / 48, w = idx - bh * 48, b = bh >> 3, h = bh & 7, p = w >> 4, v = w & 15;
                const int dil = 1 << (2 * p), Lv = SEQ / dil;
                int res, qb; if (p == 0) { res = 0; qb = v; } else if (p == 1) { res = v >> 2; qb = v & 3; } else { res = v; qb = 0; }
                att::Item it{}; it.qkv = qkv; it.tokbase = b * SEQ + res; it.dil = dil; it.q0 = 256 * qb; it.head = h;
                int t0 = 4 * qb - 1; if (t0 < 0) t0 = 0; int te = 4 * qb + 4; if (te > Lv / 64 - 1) te = Lv / 64 - 1;
                it.t0 = t0; it.nt = te - t0 + 1;
                it.coef = exp2f(-(float)(h + 1)) * (float)dil * (1.0f / 0.088388347648318440f);
                it.out = (bf16_t*)(ws + WS_APART) + (size_t)p * NTOK * 1024; it.out_ld = 1024; it.out_col = h * HD; it.lse = (float*)(ws + WS_ALSE) + (size_t)p * NTOK * 8;
                it.lam = 0.f; it.outscale = 0.f; it.subg = nullptr; it.rpb = nullptr;
                att::attn_item<0>(it, lds);
            }
        }
    }
}
__device__ __forceinline__ void ph_acombine(const Args& a, const Frame& F0, int tok0, int tend) {
    const Frame F = relaunder(F0);
    unsigned char* ws = a.ws + opq0(); const bf16_t* ap = (const bf16_t*)(ws + WS_APART); const float* lse = (const float*)(ws + WS_ALSE); bf16_t* ocat = (bf16_t*)(ws + WS_OCAT);
    const int gw = tok0, h = F.lane >> 3, c0 = (F.lane & 7) * 16;
    float nlv[3]; u32x4 nx[3][2];
#pragma unroll
    for (int p = 0; p < 3; ++p) { nlv[p] = lse[((size_t)p * NTOK + gw) * 8 + h]; const bf16_t* src = ap + ((size_t)p * NTOK + gw) * 1024 + h * HD + c0; nx[p][0] = *(const u32x4*)src; nx[p][1] = *(const u32x4*)(src + 8); }
    for (int tok = gw; tok < tend; ++tok) {
        float lv[3]; u32x4 xv[3][2]; const int tn = tok + 1 < tend ? tok + 1 : tok;
#pragma unroll
        for (int p = 0; p < 3; ++p) { lv[p] = nlv[p]; xv[p][0] = nx[p][0]; xv[p][1] = nx[p][1];
            nlv[p] = lse[((size_t)p * NTOK + tn) * 8 + h]; const bf16_t* src = ap + ((size_t)p * NTOK + tn) * 1024 + h * HD + c0; nx[p][0] = *(const u32x4*)src; nx[p][1] = *(const u32x4*)(src + 8); }
        const float m = fmaxf(lv[0], fmaxf(lv[1], lv[2]));
        float w[3]; float s = 0.f;
#pragma unroll
        for (int p = 0; p < 3; ++p) { w[p] = __expf(lv[p] - m); s += w[p]; }
        const float inv = 1.0f / s;
        float acc[16] = {};
#pragma unroll
        for (int p = 0; p < 3; ++p) { const float wp = w[p] * inv;
#pragma unroll
            for (int q = 0; q < 2; ++q) { const u32x4 x = xv[p][q];
                acc[8 * q + 0] += wp * bflo(x.x); acc[8 * q + 1] += wp * bfhi(x.x); acc[8 * q + 2] += wp * bflo(x.y); acc[8 * q + 3] += wp * bfhi(x.y);
                acc[8 * q + 4] += wp * bflo(x.z); acc[8 * q + 5] += wp * bfhi(x.z); acc[8 * q + 6] += wp * bflo(x.w); acc[8 * q + 7] += wp * bfhi(x.w); } }
        unsigned char* dst = (unsigned char*)ocat + (size_t)tok * DM + h * HD + c0;
        u32x4 o; o.x = pk4_fp8(acc[0], acc[1], acc[2], acc[3]); o.y = pk4_fp8(acc[4], acc[5], acc[6], acc[7]); o.z = pk4_fp8(acc[8], acc[9], acc[10], acc[11]); o.w = pk4_fp8(acc[12], acc[13], acc[14], acc[15]);
        *(u32x4*)dst = o;
    }
}
__device__ __forceinline__ void ph_attention2(const Args& a, const Frame& F0, int l, int qrep = 0) {
    const Frame F = relaunder(F0);
    unsigned char* ws = a.ws + opq0();
    const bf16_t* qkv = (const bf16_t*)(ws + WS_QKV);
    const float* mod = (const float*)(ws + WS_MOD);
    unsigned* ctl = (unsigned*)(ws + WS_CTL);
    LAS char* lds = (LAS char*)F.lds;
    volatile LAS int* qslot = (volatile LAS int*)(F.lds + MISC_OFF + 16);
    for (;;) {
        if (F.tid == 0) *qslot = (int)xb_add(ctl + CW_QB + 64 * l + 8 * qrep, 1u);
        __syncthreads();
        const int qi = *qslot;
        if (qi >= 512) break;
        const int h = 3 - (qi >> 7), b = (qi >> 5) & 3, qb = qi & 31;
        att::Item it{}; it.qkv = qkv; it.tokbase = b * SEQ; it.dil = 1; it.q0 = 128 * qb; it.head = 8 + h; it.t0 = 0; it.nt = SEQ / 64;
        it.coef = exp2f(-(0.5f + (float)h)) * 8.0f;
        it.out = (bf16_t*)(ws + WS_OCAT); it.out_ld = DM; it.out_col = (8 + h) * HD; it.lse = nullptr;
        it.lam = mod[NLAYER * NBATCH * MODW + l]; it.outscale = 1.0f - (0.8f - 0.6f * expf(-0.3f * (float)l)); it.subg = a.in[I_SUBG] + l * HD; it.rpb = nullptr;
        it.kmax2a = __uint_as_float(xb_ld(ctl + CW_KMAX + ((l * NBATCH + b) * 4 + h) * 2 + 0)); it.kmax2b = __uint_as_float(xb_ld(ctl + CW_KMAX + ((l * NBATCH + b) * 4 + h) * 2 + 1));
        att::attn_item<1>(it, lds);
    }
    __syncthreads();
    for (;;) {
        const int c = queue_pull(ctl + CW_QM + 64 * l + 8 * qrep, qslot, F.tid);
        if (c >= NTOK / 64) break;
        ph_acombine(a, F0, c * 64 + F.wave * 8, c * 64 + F.wave * 8 + 8);
    }
}
__device__ __forceinline__ void ph_router(const Args& a, const Frame& F0, int l) {
    const Frame F = relaunder(F0);
    unsigned char* ws = a.ws + opq0();
    const bf16_t* x1 = (const bf16_t*)(ws + WS_XA); unsigned char* hb = (unsigned char*)(ws + WS_H);
    const float* modl = (const float*)(ws + WS_MOD) + (size_t)l * NBATCH * MODW;
    const float* gffn = a.in[I_GFFN] + l * DM; const float* Wr = a.in[I_RW] + (size_t)l * DM * NE; const float* rbias = a.in[I_RB] + l * NE;
    unsigned* gcount = (unsigned*)(ws + WS_CTL) + CW_CNT + l * NE;
    int* toklist = (int*)(ws + WS_TOK); int* slot_er = (int*)(ws + WS_SLOT); float* slot_gate = (float*)(ws + WS_SLOT + 512 * 1024);
    LAS float* part = (LAS float*)F.lds;
    LAS float* logit = (LAS float*)(F.lds + 65536);
    LAS float* rstd_s = (LAS float*)(F.lds + 81920);
    LAS int* hist = (LAS int*)(F.lds + 81920 + 256);
    LAS int* basee = (LAS int*)(F.lds + 81920 + 512);
    LAS int* sl_e = (LAS int*)(F.lds + 81920 + 1024);
    LAS int* sl_lr = (LAS int*)(F.lds + 81920 + 1024 + 2048);
    LAS float* sl_g = (LAS float*)(F.lds + 81920 + 1024 + 4096);
    LAS float* gvl = (LAS float*)(F.lds + 98304);
    LAS float* svl = (LAS float*)(F.lds + 106496);
    const int lane = F.lane, wid = F.wave;
    for (int unit = F.vcu; unit < NTOK / 64; unit += F.G) {
        const int tok0 = unit * 64, b = tok0 / SEQ;
        const float* sc2 = modl + (size_t)b * MODW + 4 * DM; const float* sh2 = modl + (size_t)b * MODW + 3 * DM;
        if (F.tid < 64) hist[F.tid] = 0;
        {
            f32x4 Gv[8], Sv[8];
#pragma unroll
            for (int j = 0; j < 8; ++j) { const int col = 4 * lane + 256 * j; Gv[j] = *(const f32x4*)(gffn + col) * (1.0f + *(const f32x4*)(sc2 + col)); Sv[j] = *(const f32x4*)(sh2 + col);
                if (wid == j) { *(LAS f32x4*)(gvl + col) = Gv[j]; *(LAS f32x4*)(svl + col) = Sv[j]; } }
            u32x2 nx[8];
            { const bf16_t* xr = x1 + (size_t)(tok0 + 8 * wid) * DM + 4 * lane;
#pragma unroll
              for (int j = 0; j < 8; ++j) nx[j] = *(const u32x2*)(xr + 256 * j); }
            for (int rr = 0; rr < 8; ++rr) { const int row = tok0 + 8 * wid + rr;
                const bf16_t* xr = x1 + (size_t)(row + (rr < 7 ? 1 : 0)) * DM + 4 * lane; f32x4 v[8]; float ss = 0.f;
#pragma unroll
                for (int j = 0; j < 8; ++j) { const u32x2 xw = nx[j]; nx[j] = *(const u32x2*)(xr + 256 * j);
                    v[j].x = bflo(xw.x); v[j].y = bfhi(xw.x); v[j].z = bflo(xw.y); v[j].w = bfhi(xw.y);
                    ss += (v[j].x * v[j].x + v[j].y * v[j].y) + (v[j].z * v[j].z + v[j].w * v[j].w); }
                const float rstd = __builtin_amdgcn_rsqf(wave_sum(ss) * (1.0f / DM) + NORM_EPS);
                if (lane == 0) rstd_s[8 * wid + rr] = rstd;
                unsigned char* orow = hb + (size_t)row * DM + 4 * lane;
#pragma unroll
                for (int j = 0; j < 8; ++j) { const f32x4 h = v[j] * rstd * Gv[j] + Sv[j]; *(unsigned*)(orow + 256 * j) = pk4_fp8(h.x, h.y, h.z, h.w); } }
        }
        __syncthreads();
        {
            const int th = wid & 1, kq = wid >> 1, r = lane & 31, g = lane >> 5;
            const float rs = rstd_s[32 * th + r];
            const bf16_t* xr = x1 + (size_t)(tok0 + 32 * th + r) * DM;
            const bf16_t* wh0 = (const bf16_t*)(ws + WS_WRH) + ((size_t)l * NE + r) * DM; const bf16_t* wl0 = (const bf16_t*)(ws + WS_WRL) + ((size_t)l * NE + r) * DM;
            f32x16 acc0 = {}, acc1 = {};
#pragma unroll 4
            for (int s = 0; s < 32; ++s) { const int k = 512 * kq + 16 * s + 8 * g;
                const u32x4 xw = *(const u32x4*)(xr + k);
                float hv[8] = {bflo(xw.x), bfhi(xw.x), bflo(xw.y), bfhi(xw.y), bflo(xw.z), bfhi(xw.z), bflo(xw.w), bfhi(xw.w)};
#pragma unroll
                for (int q = 0; q < 2; ++q) { const f32x4 g4 = *(const LAS f32x4*)(gvl + k + 4 * q); const f32x4 s4 = *(const LAS f32x4*)(svl + k + 4 * q);
#pragma unroll
                    for (int t = 0; t < 4; ++t) hv[4 * q + t] = hv[4 * q + t] * rs * g4[t] + s4[t]; }
                u32x4 ah, al;
#pragma unroll
                for (int q = 0; q < 4; ++q) { const unsigned hp = cvt_pk_bf16(hv[2 * q], hv[2 * q + 1]); const float l0 = hv[2 * q] - bflo(hp), l1 = hv[2 * q + 1] - bfhi(hp); ah[q] = hp; al[q] = cvt_pk_bf16(l0, l1); }
                const bf16x8 Ah = __builtin_bit_cast(bf16x8, ah), Al = __builtin_bit_cast(bf16x8, al);
                const bf16x8 Bh0 = *(const bf16x8*)(wh0 + k), Bl0 = *(const bf16x8*)(wl0 + k), Bh1 = *(const bf16x8*)(wh0 + (size_t)32 * DM + k), Bl1 = *(const bf16x8*)(wl0 + (size_t)32 * DM + k);
                acc0 = __builtin_amdgcn_mfma_f32_32x32x16_bf16(Ah, Bh0, acc0, 0, 0, 0); acc1 = __builtin_amdgcn_mfma_f32_32x32x16_bf16(Ah, Bh1, acc1, 0, 0, 0);
                acc0 = __builtin_amdgcn_mfma_f32_32x32x16_bf16(Ah, Bl0, acc0, 0, 0, 0); acc1 = __builtin_amdgcn_mfma_f32_32x32x16_bf16(Ah, Bl1, acc1, 0, 0, 0);
                acc0 = __builtin_amdgcn_mfma_f32_32x32x16_bf16(Al, Bh0, acc0, 0, 0, 0); acc1 = __builtin_amdgcn_mfma_f32_32x32x16_bf16(Al, Bh1, acc1, 0, 0, 0); }
#pragma unroll
            for (int i = 0; i < 16; ++i) { const int tl = 32 * th + (i & 3) + 8 * (i >> 2) + 4 * g;
                part[(kq * 64 + tl) * 64 + r] = acc0[i]; part[(kq * 64 + tl) * 64 + 32 + r] = acc1[i]; }
        }
        __syncthreads();
#pragma unroll
        for (int i = 0; i < 8; ++i) { const int o = F.tid + 512 * i; logit[o] = (part[o] + part[4096 + o]) + (part[8192 + o] + part[12288 + o]); }
        __syncthreads();
        for (int tt = 0; tt < 8; ++tt) { const int tl = 8 * wid + tt;
            const float lg = logit[tl * 64 + lane]; const float sgm = 1.0f / (1.0f + __expf(-lg)); const float sel = sgm + rbias[lane];
            const float m1 = gmax8(sel);
            const int i1 = gmin8((sel == m1) ? lane : 64);
            const float m2 = gmax8((lane == i1) ? -3.0e38f : sel);
            const float gs = m1 + m2; const int myg = lane >> 3; int gr = 0;
#pragma unroll
            for (int g2 = 0; g2 < 8; ++g2) { const float og = rdl(gs, g2 * 8); gr += (og > gs || (og == gs && g2 < myg)) ? 1 : 0; }
            const float selm = gr < 4 ? sel : -1e30f; int rank = 0;
#pragma unroll 8
            for (int e2 = 0; e2 < 64; ++e2) { const float os = rdl(selm, e2); rank += (os > selm || (os == selm && e2 < lane)) ? 1 : 0; }
            const bool chosen = rank < TOPK;
            const float ssum = wave_sum(chosen ? sgm : 0.f);
            if (chosen) { const int lr = __hip_atomic_fetch_add(&hist[lane], 1, __ATOMIC_RELAXED, __HIP_MEMORY_SCOPE_WORKGROUP); sl_e[tl * 8 + rank] = lane; sl_lr[tl * 8 + rank] = lr; sl_g[tl * 8 + rank] = sgm / ssum * 2.5f; }
        }
        __syncthreads();
        if (F.tid < 64) { const int hc = hist[F.tid]; basee[F.tid] = hc > 0 ? (int)xb_add(gcount + F.tid, (unsigned)hc) : 0; }
        __syncthreads();
        { const int tl = F.tid >> 3, sl = F.tid & 7, e = sl_e[tl * 8 + sl], rank = basee[e] + sl_lr[tl * 8 + sl], tok = tok0 + tl;
          toklist[(size_t)e * NTOK + rank] = tok; slot_er[(size_t)tok * 8 + sl] = e * NTOK + rank; slot_gate[(size_t)tok * 8 + sl] = sl_g[tl * 8 + sl]; }
        __syncthreads();
    }
}
__device__ __forceinline__ void moe_tables(const Args& a, const Frame& F0, int l) {
    const Frame F = relaunder(F0);
    LAS int* bs = (LAS int*)(F.lds + TAB_BS_OFF); LAS int* cn = (LAS int*)(F.lds + TAB_CNT_OFF);
    unsigned* gcount = (unsigned*)(a.ws + WS_CTL) + CW_CNT + l * NE;
    if (F.tid < NE) cn[F.tid] = (int)xb_ld(gcount + F.tid);
    if (F.tid == NE) cn[NE] = NTOK;
    __syncthreads();
    if (F.tid == 0) { int acc = 0; for (int e = 0; e < NEX; ++e) { bs[e] = acc; acc += (cn[e] + 255) >> 8; } bs[NEX] = acc; }
    __syncthreads();
}
__device__ __forceinline__ void ph_combine(const Args& a, const Frame& F0, int l) {
    const Frame F = relaunder(F0);
    unsigned char* ws = a.ws + opq0();
    const LAS int* bs = (const LAS int*)(F.lds + TAB_BS_OFF);
    const bf16_t* x1 = (const bf16_t*)(ws + WS_XA); bf16_t* x2 = (bf16_t*)(ws + WS_XB); bf16_t* hb = (bf16_t*)(ws + WS_H);
    const unsigned char* yb = (const unsigned char*)(ws + WS_YBUF);
    const int* slot_er = (const int*)(ws + WS_SLOT); const float* slot_gate = (const float*)(ws + WS_SLOT + 512 * 1024);
    const float* modl = (const float*)(ws + WS_MOD) + (size_t)l * NBATCH * MODW;
    const bool last = (l == NLAYER - 1);
    const float* modn = (const float*)(ws + WS_MOD) + (size_t)(last ? l : l + 1) * NBATCH * MODW;
    const float* gnext = last ? a.in[I_FG] : a.in[I_GMIX] + (l + 1) * DM;
    const int gw = F.vcu * 8 + F.wave, NGW = F.G * 8, lane = F.lane;
    const int shbase = bs[NE] * 256;
    LAS float* const T = (LAS float*)F.lds;
    {
        const int col = 4 * F.tid;
        const f32x4 gn = *(const f32x4*)(gnext + col);
#pragma unroll
        for (int b = 0; b < NBATCH; ++b) {
            const f32x4 g2 = *(const f32x4*)(modl + (size_t)b * MODW + 5 * DM + col);
            f32x4 gv = gn, hv4 = (f32x4){0.f, 0.f, 0.f, 0.f};
            if (!last) { const f32x4 s4 = *(const f32x4*)(modn + (size_t)b * MODW + 1 * DM + col); hv4 = *(const f32x4*)(modn + (size_t)b * MODW + col);
                gv.x = gn.x * (1.0f + s4.x); gv.y = gn.y * (1.0f + s4.y); gv.z = gn.z * (1.0f + s4.z); gv.w = gn.w * (1.0f + s4.w); }
            *(LAS f32x4*)(T + (b * 3 + 0) * DM + col) = g2; *(LAS f32x4*)(T + (b * 3 + 1) * DM + col) = gv; *(LAS f32x4*)(T + (b * 3 + 2) * DM + col) = hv4; }
    }
    __syncthreads();
    int er_n = slot_er[(size_t)gw * 8 + (lane & 7)]; float gt_n = slot_gate[(size_t)gw * 8 + (lane & 7)];
    for (int tok = gw; tok < NTOK; tok += NGW) {
        const int b = tok / SEQ;
        const int er = er_n; const float gt = gt_n;
        { const int tn = tok + NGW < NTOK ? tok + NGW : tok; er_n = slot_er[(size_t)tn * 8 + (lane & 7)]; gt_n = slot_gate[(size_t)tn * 8 + (lane & 7)]; }
        u32x4 xw[2][2];
#pragma unroll
        for (int j = 0; j < 2; ++j)
#pragma unroll
            for (int hq = 0; hq < 2; ++hq) xw[j][hq] = *(const u32x4*)(x1 + (size_t)tok * DM + 16 * lane + 1024 * j + 8 * hq);
        float acc[2][16];
#pragma unroll
        for (int j = 0; j < 2; ++j)
#pragma unroll
            for (int t = 0; t < 16; ++t) acc[j][t] = 0.f;
#pragma unroll
        for (int s = 0; s < 9; ++s) {
            int pos; float g;
            if (s < 8) { const int ers = shf(er, s); g = shf(gt, s); pos = bs[ers >> 14] * 256 + (ers & (NTOK - 1)); } else { pos = shbase + tok; g = 1.0f; }
            const unsigned char* yr = yb + (size_t)pos * DM + 16 * lane;
#pragma unroll
            for (int j = 0; j < 2; ++j) { const u32x4 y = __builtin_nontemporal_load((const u32x4*)(yr + 1024 * j));
#pragma unroll
                for (int q = 0; q < 4; ++q) { const f32x2 lo = __builtin_amdgcn_cvt_pk_f32_fp8((int)y[q], false), hi = __builtin_amdgcn_cvt_pk_f32_fp8((int)y[q], true);
                    acc[j][4 * q + 0] += g * lo.x; acc[j][4 * q + 1] += g * lo.y; acc[j][4 * q + 2] += g * hi.x; acc[j][4 * q + 3] += g * hi.y; } }
        }
        const LAS float* Tb = T + b * 3 * DM + 16 * lane;
        float ss = 0.f;
#pragma unroll
        for (int j = 0; j < 2; ++j) { const int col = 16 * lane + 1024 * j;
#pragma unroll
            for (int hq = 0; hq < 2; ++hq) { const u32x4 w = xw[j][hq];
#pragma unroll
                for (int q = 0; q < 2; ++q) { const f32x4 g2 = *(const LAS f32x4*)(Tb + 1024 * j + 8 * hq + 4 * q); const int t = 8 * hq + 4 * q;
                    const float r0 = bflo(w[2 * q]) + g2.x * acc[j][t], r1 = bfhi(w[2 * q]) + g2.y * acc[j][t + 1], r2 = bflo(w[2 * q + 1]) + g2.z * acc[j][t + 2], r3 = bfhi(w[2 * q + 1]) + g2.w * acc[j][t + 3];
                    acc[j][t] = r0; acc[j][t + 1] = r1; acc[j][t + 2] = r2; acc[j][t + 3] = r3; ss += (r0 * r0 + r1 * r1) + (r2 * r2 + r3 * r3); } }
            if (!last) { u32x4 o0, o1; o0.x = cvt_pk_bf16(acc[j][0], acc[j][1]); o0.y = cvt_pk_bf16(acc[j][2], acc[j][3]); o0.z = cvt_pk_bf16(acc[j][4], acc[j][5]); o0.w = cvt_pk_bf16(acc[j][6], acc[j][7]);
                o1.x = cvt_pk_bf16(acc[j][8], acc[j][9]); o1.y = cvt_pk_bf16(acc[j][10], acc[j][11]); o1.z = cvt_pk_bf16(acc[j][12], acc[j][13]); o1.w = cvt_pk_bf16(acc[j][14], acc[j][15]);
                *(u32x4*)(x2 + (size_t)tok * DM + col) = o0; *(u32x4*)(x2 + (size_t)tok * DM + col + 8) = o1; } }
        const float rstd = __builtin_amdgcn_rsqf(wave_sum(ss) * (1.0f / DM) + NORM_EPS);
#pragma unroll
        for (int j = 0; j < 2; ++j) { const int col = 16 * lane + 1024 * j;
            if (last) {
#pragma unroll
                for (int q = 0; q < 4; ++q) { const f32x4 g4 = *(const LAS f32x4*)(Tb + DM + 1024 * j + 4 * q); f32x4 o; o.x = acc[j][4 * q + 0] * rstd * g4.x; o.y = acc[j][4 * q + 1] * rstd * g4.y; o.z = acc[j][4 * q + 2] * rstd * g4.z; o.w = acc[j][4 * q + 3] * rstd * g4.w;
                    *(f32x4*)(a.out + (size_t)tok * DM + col + 4 * q) = o; }
            } else {
                float hv[16];
#pragma unroll
                for (int q = 0; q < 4; ++q) { const f32x4 g4 = *(const LAS f32x4*)(Tb + DM + 1024 * j + 4 * q), h4 = *(const LAS f32x4*)(Tb + 2 * DM + 1024 * j + 4 * q);
                    hv[4 * q + 0] = acc[j][4 * q + 0] * rstd * g4.x + h4.x; hv[4 * q + 1] = acc[j][4 * q + 1] * rstd * g4.y + h4.y;
                    hv[4 * q + 2] = acc[j][4 * q + 2] * rstd * g4.z + h4.z; hv[4 * q + 3] = acc[j][4 * q + 3] * rstd * g4.w + h4.w; }
                u32x4 o0; o0.x = pk4_fp8(hv[0], hv[1], hv[2], hv[3]); o0.y = pk4_fp8(hv[4], hv[5], hv[6], hv[7]); o0.z = pk4_fp8(hv[8], hv[9], hv[10], hv[11]); o0.w = pk4_fp8(hv[12], hv[13], hv[14], hv[15]);
                *(u32x4*)((unsigned char*)hb + (size_t)tok * DM + col) = o0;
            }
        }
    }
}

__global__ void __launch_bounds__(512, 2) fwd_kernel(Args args) {
    extern __shared__ __attribute__((aligned(16))) unsigned char lds_raw[];
    Frame F; F.lds = (LAS unsigned char*)lds_raw; F.tid = threadIdx.x; F.lane = F.tid & 63; F.wave = __builtin_amdgcn_readfirstlane(F.tid >> 6);
    F.G = gridDim.x; { const int bx = blockIdx.x; F.vcu = (F.G % 8 == 0) ? (bx % 8) * (F.G / 8) + bx / 8 : bx; }
    unsigned char* ws = args.ws;
    unsigned* ctl = (unsigned*)(ws + WS_CTL);
    if (F.tid < 4) ((LAS unsigned*)(F.lds + MISC_OFF))[F.tid] = 0u;
    __syncthreads();
    const int lo = args.ph_lo, hi = args.ph_hi;
    XcdBarrier bar; bar.bar = ctl + CW_BAR; bar.x = 0; bar.st = nullptr;
    if (hi - lo > 1) bar = xcd_barrier_post(ctl + CW_BAR, (volatile LAS unsigned*)(F.lds + MISC_OFF));
#ifndef PH_ONLY
#define PH_ONLY -1
#endif
#define PEN(c) (PH_ONLY < 0 || PH_ONLY == (c))
#ifndef DUP_MASK
#define DUP_MASK 0
#endif
#define REPS(c) (1 + ((DUP_MASK >> (c)) & 1))
#define DUPSEAM(c, k) do { if (rep_ + 1 < REPS(c)) xcd_barrier(bar); else SEAM(k); } while (0)
#define IN(k) (lo <= (k) && (k) < hi)
#define BOTH(k) (IN(k) && IN((k) + 1))
#define SEAM(k) do { if (BOTH(k)) xcd_barrier(bar); } while (0)
    if (PEN(0) && IN(0)) for (int rep_ = 0; rep_ < REPS(0); ++rep_) { ph_prologue(args, F); DUPSEAM(0, 0); }
    if (PEN(1) && IN(1)) { const float* mod0 = (const float*)(ws + WS_MOD); ph_norm(F, args.in[I_X], args.in[I_GMIX], mod0, 0, DM, (bf16_t*)(ws + WS_H)); SEAM(1); }
    unsigned char* const ws0 = ws;
    const Args args0 = args;
    for (int l = 0; l < NLAYER; ++l) {
        const int pb = 2 + 8 * l;
        size_t wz = 0; asm volatile("" : "+s"(wz));
        unsigned char* const ws = ws0 + wz;
        Args args = args0; args.ws = ws;
        const float* modl = (const float*)(ws + WS_MOD) + (size_t)l * NBATCH * MODW;
        if (PEN(2) && IN(pb + 0)) for (int rep_ = 0; rep_ < REPS(2); ++rep_) {
            unsigned char* const ws = args.ws + opq0();
            pg8::SchedPlain S; S.init(ws + WS_H, (const unsigned char*)(ws + WS_WIN) + (size_t)l * QKVW * DM, NTOK, QKVW, DM, 1, F.G, (int)blockIdx.x);
            pg8::EpiBf16 E{(bf16_t*)(ws + WS_QKV), QKVW, 0.18033688011112042f};
            pg8::gemm_phase<DM, true>(F.lds, S, E);
            DUPSEAM(2, pb + 0);
        }
        if (PEN(3) && IN(pb + 1)) for (int rep_ = 0; rep_ < REPS(3); ++rep_) { ph_attention1(args, F, l, rep_); DUPSEAM(3, pb + 1); }
        if (PEN(10) && IN(pb + 2)) for (int rep_ = 0; rep_ < REPS(10); ++rep_) { ph_attention2(args, F, l, rep_); DUPSEAM(10, pb + 2); }
        if (PEN(5) && IN(pb + 3)) for (int rep_ = 0; rep_ < REPS(5); ++rep_) {
            unsigned char* const ws = args.ws + opq0();
            pg8::SchedPlain S; S.init(ws + WS_OCAT, (const unsigned char*)(ws + WS_WOUT) + (size_t)l * DM * DM, NTOK, DM, DM, 1, F.G, (int)blockIdx.x);
            pg8::EpiResid E{l == 0 ? args.in[I_X] : nullptr, l == 0 ? nullptr : (const bf16_t*)(ws + WS_XB), (bf16_t*)(ws + WS_XA), modl + 2 * DM};
            pg8::gemm_phase<DM, true>(F.lds, S, E);
            DUPSEAM(5, pb + 3);
        }
        if (PEN(6) && IN(pb + 4)) { ph_router(args, F, l); SEAM(pb + 4); }
        if (PEN(7) && IN(pb + 5)) for (int rep_ = 0; rep_ < REPS(7); ++rep_) {
            moe_tables(args, F, l);
            unsigned char* const ws = args.ws + opq0();
            pg8::SchedMoE<true> S; S.abase = (const char*)(ws + WS_H); S.wbase = (const char*)(ws + WS_WGU) + (size_t)l * NEX * 1024 * DM; S.wstride = (size_t)1024 * DM;
            S.toklist = (const int*)(ws + WS_TOK); S.bs = (const LAS int*)(F.lds + TAB_BS_OFF); S.cn = (const LAS int*)(F.lds + TAB_CNT_OFF); S.npn = 4; S.G = F.G; S.c = F.vcu; S.rb = DM; S.ut = (const LAS int*)(F.lds + TAB_UNIT_OFF); S.build_units((LAS int*)(F.lds + TAB_UNIT_OFF), F.tid);
            pg8::EpiSwiglu E{(unsigned char*)(ws + WS_UBUF)};
            pg8::gemm_phase<DM, true>(F.lds, S, E);
            DUPSEAM(7, pb + 5);
        }
        if (PEN(8) && IN(pb + 6)) for (int rep_ = 0; rep_ < REPS(8); ++rep_) {
            moe_tables(args, F, l);
            unsigned char* const ws = args.ws + opq0();
            pg8::SchedMoE<false> S; S.abase = (const char*)(ws + WS_UBUF); S.wbase = (const char*)(ws + WS_WD) + (size_t)l * NEX * DM * EDIM; S.wstride = (size_t)DM * EDIM;
            S.toklist = nullptr; S.bs = (const LAS int*)(F.lds + TAB_BS_OFF); S.cn = (const LAS int*)(F.lds + TAB_CNT_OFF); S.npn = 8; S.G = F.G; S.c = F.vcu; S.rb = EDIM; S.ut = (const LAS int*)(F.lds + TAB_UNIT_OFF); S.build_units((LAS int*)(F.lds + TAB_UNIT_OFF), F.tid);
            pg8::EpiF8 E{(unsigned char*)(ws + WS_YBUF), DM};
            pg8::gemm_phase<EDIM, true>(F.lds, S, E);
            DUPSEAM(8, pb + 6);
        }
        if (PEN(9) && IN(pb + 7)) for (int rep_ = 0; rep_ < REPS(9); ++rep_) { moe_tables(args, F, l); ph_combine(args, F, l); DUPSEAM(9, pb + 7); }
    }
#undef IN
#undef BOTH
#undef SEAM
}

extern "C" void kernel_launch(void* const* d_in, const int* in_sizes, int n_in, void* d_out, int out_size, void* d_ws, size_t ws_size, hipStream_t stream) {
    static int grid = 0;
    if (grid == 0) {
        if (n_in != 23 || out_size != NTOK * DM || ws_size < WS_END) { fprintf(stderr, "kernel_launch: unexpected shapes (n_in %d out %d ws %zu, need %zu)\n", n_in, out_size, ws_size, (size_t)WS_END); grid = -1; return; }
        int dev = 0, cus = 0;
        if (hipGetDevice(&dev) != hipSuccess || hipDeviceGetAttribute(&cus, hipDeviceAttributeMultiprocessorCount, dev) != hipSuccess) { grid = -1; return; }
        if (hipFuncSetAttribute((const void*)fwd_kernel, hipFuncAttributeMaxDynamicSharedMemorySize, LDS_BYTES) != hipSuccess) { fprintf(stderr, "kernel_launch: hipFuncSetAttribute failed\n"); grid = -1; return; }
        int per_cu = 0;
        if (hipOccupancyMaxActiveBlocksPerMultiprocessor(&per_cu, (const void*)fwd_kernel, 512, LDS_BYTES) != hipSuccess || per_cu < 1) { fprintf(stderr, "kernel_launch: occupancy query says %d\n", per_cu); }
        (void)hipGetLastError();
        grid = cus;
    }
    if (grid < 0) return;
    if (hipMemsetAsync((char*)d_ws + WS_CTL, 0, CTL_ZERO_BYTES, stream) != hipSuccess) return;
    Args a{};
    for (int i = 0; i < 23; ++i) a.in[i] = (const float*)d_in[i];
    a.out = (float*)d_out; a.ws = (unsigned char*)d_ws;
#if MK_PER_PHASE
    for (int p = 0; p < N_PHASES; ++p) { a.ph_lo = p; a.ph_hi = p + 1; hipLaunchKernelGGL(fwd_kernel, dim3(grid), dim3(512), LDS_BYTES, stream, a); }
#else
    a.ph_lo = 0; a.ph_hi = N_PHASES;
    hipLaunchKernelGGL(fwd_kernel, dim3(grid), dim3(512), LDS_BYTES, stream, a);
#endif
}
```
